# Optimizing an MI355X kernel written in HIP

```python
import math
import jax, jax.numpy as jnp
from jax import lax
import numpy as np

D_MODEL = 1024
BATCH = 16
SEQ = 4096
DEPTH = 4

PLE_DIM = 256
HEAD_DIM = 64
N_Q_HEADS = 8
N_KV_HEADS = 2
GQA_GROUP = N_Q_HEADS // N_KV_HEADS
WINDOW = 128
BLOCK = 128
ROPE_THETA = 500000.0
ROPE_DIM = HEAD_DIM // 4
Q_WIDTH = N_Q_HEADS * HEAD_DIM
KV_WIDTH = N_KV_HEADS * HEAD_DIM
SSM_WIDTH = D_MODEL // 4
SSM_GROUP = 16
SSM_GROUPS = SSM_WIDTH // SSM_GROUP
SSM_STATE = 64
CONV_WIDTH = D_MODEL // 4
CONV_K = 31
FFN_HIDDEN = ((-(-8 * D_MODEL // 3) + 255) // 256) * 256
N_BRANCH = 3
IN_WIDTHS = [Q_WIDTH, KV_WIDTH, KV_WIDTH, SSM_WIDTH, 2 * CONV_WIDTH, N_BRANCH * D_MODEL]
IN_WIDTH = sum(IN_WIDTHS)
SPLIT_POINTS = [int(v) for v in np.cumsum(IN_WIDTHS)[:-1]]
EPS = 1e-6
NEG_INF = -1e30

kernel_name = "hybrid_gated_swa_s5_conformer_block"


def rms_norm(t, g):
    t32 = t.astype(jnp.float32)
    out = t32 * lax.rsqrt(jnp.mean(t32 * t32, axis=-1, keepdims=True) + EPS) * g.astype(jnp.float32)
    return out.astype(t.dtype)


def layer_norm(t, g, b):
    t32 = t.astype(jnp.float32)
    mu = jnp.mean(t32, axis=-1, keepdims=True)
    var = jnp.mean(jnp.square(t32 - mu), axis=-1, keepdims=True)
    out = (t32 - mu) * lax.rsqrt(var + EPS) * g.astype(jnp.float32) + b.astype(jnp.float32)
    return out.astype(t.dtype)


def partial_rope(t, cos, sin):
    half = ROPE_DIM // 2
    t1 = t[..., :half]
    t2 = t[..., half:ROPE_DIM]
    return jnp.concatenate([t1 * cos - t2 * sin, t2 * cos + t1 * sin, t[..., ROPE_DIM:]], axis=-1)


def sliding_window_attention(q, k, v, sinks):
    b, s = q.shape[0], q.shape[1]
    nb = s // BLOCK
    qb = q.reshape(b, nb, BLOCK, N_KV_HEADS, GQA_GROUP, HEAD_DIM)

    def band(t):
        tb = t.reshape(b, nb, BLOCK, N_KV_HEADS, HEAD_DIM)
        prev = jnp.pad(tb, ((0, 0), (1, 0), (0, 0), (0, 0), (0, 0)))[:, :-1]
        return jnp.concatenate([prev, tb], axis=2)

    kb, vb = band(k), band(v)
    scores = jnp.einsum('bnqkgd,bnjkd->bnkgqj', qb, kb) * (HEAD_DIM ** -0.5)
    qi = jnp.arange(BLOCK)[:, None]
    kj = jnp.arange(2 * BLOCK)[None, :]
    dist = qi + BLOCK - kj
    in_window = (dist >= 0) & (dist < WINDOW)
    has_prev = (jnp.arange(nb)[:, None, None] > 0) | (kj[None] >= BLOCK)
    mask = in_window[None] & has_prev
    scores = jnp.where(mask[None, :, None, None], scores, NEG_INF)
    sink = sinks.astype(jnp.float32).reshape(N_KV_HEADS, GQA_GROUP)[None, None, :, :, None, None]
    m = jnp.maximum(jnp.max(scores, axis=-1, keepdims=True), sink)
    pr = jnp.exp(scores - m)
    denom = jnp.sum(pr, axis=-1, keepdims=True) + jnp.exp(sink - m)
    out = jnp.einsum('bnkgqj,bnjkd->bnqkgd', pr / denom, vb)
    return out.reshape(b, s, Q_WIDTH)


def s5_ssm(u, lam_re, lam_im, log_dt, b_re, b_im, c_re, c_im, d_skip):
    b, s, _ = u.shape
    ug = u.reshape(b, s, SSM_GROUPS, SSM_GROUP)
    lr = jnp.minimum(lam_re.astype(jnp.float32), -1e-4)
    li = lam_im.astype(jnp.float32)
    dt = jnp.exp(log_dt.astype(jnp.float32))[:, None]
    mag = jnp.exp(lr * dt)
    a_re = mag * jnp.cos(li * dt)
    a_im = mag * jnp.sin(li * dt)
    den = lr * lr + li * li
    x_re, x_im = a_re - 1.0, a_im
    f_re = (x_re * lr + x_im * li) / den
    f_im = (x_im * lr - x_re * li) / den
    br = b_re.astype(jnp.float32)
    bi = b_im.astype(jnp.float32)
    bb_re = f_re[..., None] * br - f_im[..., None] * bi
    bb_im = f_re[..., None] * bi + f_im[..., None] * br
    bu_re = jnp.einsum('bsgh,gnh->bsgn', ug, bb_re)
    bu_im = jnp.einsum('bsgh,gnh->bsgn', ug, bb_im)
    a_re_t = jnp.broadcast_to(a_re, (1, s) + a_re.shape)
    a_im_t = jnp.broadcast_to(a_im, (1, s) + a_im.shape)

    def combine(e1, e2):
        a1r, a1i, b1r, b1i = e1
        a2r, a2i, b2r, b2i = e2
        return (a2r * a1r - a2i * a1i, a2r * a1i + a2i * a1r,
                a2r * b1r - a2i * b1i + b2r, a2r * b1i + a2i * b1r + b2i)

    _, _, st_re, st_im = lax.associative_scan(combine, (a_re_t, a_im_t, bu_re, bu_im), axis=1)
    y = (jnp.einsum('bsgn,ghn->bsgh', st_re, c_re.astype(jnp.float32))
         - jnp.einsum('bsgn,ghn->bsgh', st_im, c_im.astype(jnp.float32)))
    return y.reshape(b, s, SSM_WIDTH) + d_skip.astype(jnp.float32) * u


def conformer_conv(c_in, dw_w, dw_b, ln_g, ln_b, w_pw_out):
    a, g = jnp.split(c_in, 2, axis=-1)
    u = a * jax.nn.sigmoid(g)
    u = lax.conv_general_dilated(u, dw_w[:, None, :].astype(u.dtype), window_strides=(1,),
                                 padding=[(CONV_K - 1, 0)],
                                 dimension_numbers=('NWC', 'WIO', 'NWC'),
                                 feature_group_count=CONV_WIDTH) + dw_b
    u = jax.nn.silu(layer_norm(u, ln_g, ln_b))
    return u @ w_pw_out


def setup_inputs(seed: int = 0) -> dict:
    key = jax.random.key(seed)
    ks = iter(jax.random.split(key, 40))
    f32 = jnp.float32

    def nrm(shape, scale):
        return jax.random.normal(next(ks), shape, f32) * scale

    L, D = DEPTH, D_MODEL
    x = nrm((BATCH, SEQ, D), 1.0)
    p = nrm((DEPTH, BATCH, SEQ, PLE_DIM), 1.0)
    positions = (jnp.arange(SEQ, dtype=jnp.int32)[None, :]
                 + jax.random.randint(next(ks), (BATCH, 1), 0, 1024, dtype=jnp.int32))
    n_idx = jnp.arange(SSM_STATE, dtype=f32)
    return {
        'x': x,
        'p': p,
        'positions': positions,
        'mix_norm_g': 1.0 + nrm((L, D), 0.02),
        'w_in': nrm((L, D, IN_WIDTH), D ** -0.5),
        'b_gate': nrm((L, N_BRANCH * D), 0.02),
        'attn_sinks': nrm((L, N_Q_HEADS), 0.5),
        'w_attn_out': nrm((L, Q_WIDTH, D), Q_WIDTH ** -0.5),
        'ssm_lambda_re': -0.5 + nrm((L, SSM_GROUPS, SSM_STATE), 0.01),
        'ssm_lambda_im': math.pi * n_idx + nrm((L, SSM_GROUPS, SSM_STATE), 0.01),
        'ssm_log_dt': jax.random.uniform(next(ks), (L, SSM_GROUPS), f32, math.log(1e-3), math.log(1e-1)),
        'ssm_b_re': nrm((L, SSM_GROUPS, SSM_STATE, SSM_GROUP), (2 * SSM_GROUP) ** -0.5),
        'ssm_b_im': nrm((L, SSM_GROUPS, SSM_STATE, SSM_GROUP), (2 * SSM_GROUP) ** -0.5),
        'ssm_c_re': nrm((L, SSM_GROUPS, SSM_GROUP, SSM_STATE), (2 * SSM_STATE) ** -0.5),
        'ssm_c_im': nrm((L, SSM_GROUPS, SSM_GROUP, SSM_STATE), (2 * SSM_STATE) ** -0.5),
        'ssm_d': nrm((L, SSM_WIDTH), 1.0),
        'w_ssm_glu': nrm((L, SSM_WIDTH, 2 * D), SSM_WIDTH ** -0.5),
        'b_ssm_glu': nrm((L, 2 * D), 0.02),
        'conv_dw_w': nrm((L, CONV_K, CONV_WIDTH), CONV_K ** -0.5),
        'conv_dw_b': nrm((L, CONV_WIDTH), 0.02),
        'conv_norm_g': 1.0 + nrm((L, CONV_WIDTH), 0.02),
        'conv_norm_b': nrm((L, CONV_WIDTH), 0.02),
        'w_conv_out': nrm((L, CONV_WIDTH, D), CONV_WIDTH ** -0.5),
        'w_mix_out': nrm((L, D, D), D ** -0.5),
        'ffn_norm_g': 1.0 + nrm((L, D), 0.02),
        'w_ffn_in': nrm((L, D, 2 * FFN_HIDDEN), D ** -0.5),
        'w_ffn_out': nrm((L, FFN_HIDDEN, D), FFN_HIDDEN ** -0.5),
        'w_ple_in': nrm((L, PLE_DIM, D), PLE_DIM ** -0.5),
        'ple_norm_g': 1.0 + nrm((L, D), 0.02),
        'w_ple_gate': nrm((L, D, D), D ** -0.5),
        'final_norm_g': 1.0 + nrm((D,), 0.02),
    }


def reference(x, p, positions, mix_norm_g, w_in, b_gate, attn_sinks, w_attn_out,
              ssm_lambda_re, ssm_lambda_im, ssm_log_dt, ssm_b_re, ssm_b_im, ssm_c_re, ssm_c_im,
              ssm_d, w_ssm_glu, b_ssm_glu, conv_dw_w, conv_dw_b, conv_norm_g, conv_norm_b,
              w_conv_out, w_mix_out, ffn_norm_g, w_ffn_in, w_ffn_out, w_ple_in, ple_norm_g,
              w_ple_gate, final_norm_g):
    f32 = jnp.float32
    b, s, d = x.shape
    inv_freq = ROPE_THETA ** (-jnp.arange(0, ROPE_DIM, 2, dtype=f32) / ROPE_DIM)
    ang = positions.astype(f32)[..., None] * inv_freq
    cos = jnp.cos(ang)[:, :, None, :]
    sin = jnp.sin(ang)[:, :, None, :]

    for i in range(DEPTH):
        h = rms_norm(x, mix_norm_g[i])
        z = h @ w_in[i]
        q, k, v, s_in, c_in, g_in = jnp.split(z, SPLIT_POINTS, axis=-1)

        qh = partial_rope(q.astype(f32).reshape(b, s, N_Q_HEADS, HEAD_DIM), cos, sin)
        kh = partial_rope(k.astype(f32).reshape(b, s, N_KV_HEADS, HEAD_DIM), cos, sin)
        vh = v.astype(f32).reshape(b, s, N_KV_HEADS, HEAD_DIM)
        y_attn = sliding_window_attention(qh, kh, vh, attn_sinks[i]).astype(x.dtype) @ w_attn_out[i]

        y_s = s5_ssm(s_in.astype(f32), ssm_lambda_re[i], ssm_lambda_im[i], ssm_log_dt[i],
                     ssm_b_re[i], ssm_b_im[i], ssm_c_re[i], ssm_c_im[i], ssm_d[i])
        glu_a, glu_b = jnp.split(jax.nn.gelu(y_s).astype(x.dtype) @ w_ssm_glu[i] + b_ssm_glu[i], 2, axis=-1)
        y_ssm = glu_a * jax.nn.sigmoid(glu_b)

        y_conv = conformer_conv(c_in, conv_dw_w[i], conv_dw_b[i], conv_norm_g[i], conv_norm_b[i], w_conv_out[i])

        gates = jax.nn.sigmoid(g_in + b_gate[i]).reshape(b, s, N_BRANCH, d)
        merged = gates[:, :, 0] * y_attn + gates[:, :, 1] * y_ssm + gates[:, :, 2] * y_conv
        x = x + merged @ w_mix_out[i]

        hf = rms_norm(x, ffn_norm_g[i])
        f_gate, f_up = jnp.split(hf @ w_ffn_in[i], 2, axis=-1)
        x = x + (jax.nn.silu(f_gate) * f_up) @ w_ffn_out[i]

        e = p[i] @ w_ple_in[i]
        g_ple = jax.nn.sigmoid(rms_norm(x, ple_norm_g[i]) @ w_ple_gate[i])
        x = x + g_ple * e

    return rms_norm(x, final_norm_g)
```

```cpp
#include <hip/hip_runtime.h>
#include <hip/hip_cooperative_groups.h>
#include <cstdio>
#include <cstdint>
#include <cmath>
namespace cg = cooperative_groups;
namespace pg8 {
#define PG8_LAS __attribute__((address_space(3)))
typedef unsigned short bf16_t;
typedef short bf16x8 __attribute__((ext_vector_type(8)));
typedef float f32x4 __attribute__((ext_vector_type(4)));
typedef unsigned u32x4 __attribute__((ext_vector_type(4)));
constexpr int BM = 256, BK = 64, HALF = 128, HTB = HALF * BK * 2  , STAGE_BYTES = 8 * HTB, NXCD = 8, WGM = 8;

__host__ __device__ __forceinline__ int lds_byte(int r, int c) { const int st = (r >> 4) * 2 + (c >> 5), rr = r & 15, cc = c & 31, ob = rr * 64 + cc * 2; return st * 1024 + (ob ^ (((ob >> 9) & 1) << 5)); }
__host__ __device__ __forceinline__ void stage_rc(int b, int& R, int& C) { const int st = b / 1024, sb = b % 1024, swz = sb ^ (((sb >> 9) & 1) << 5); R = (st >> 1) * 16 + swz / 64; C = (st & 1) * 32 + (swz % 64) / 2; }
__host__ __device__ __forceinline__ int perm32(int rho) { const int n = rho >> 4, i = rho & 15; return 8 * (i >> 2) + 4 * n + (i & 3); }

struct Unit { int pm, pn; };
struct Gemm { const bf16_t* A; const bf16_t* Bt; int M, N, K; };

struct StaticOrder {
    int nM, nN, nwg, G, c;
    __host__ __device__ void init(int M, int N, int G_, int c_) { nM = M / BM; nN = N / BM; nwg = nM * nN; G = G_; c = c_; }
    __host__ __device__ bool next(int i, Unit& u) const {
        const long L = (long)i * G + c; if (L >= nwg) return false;
        int wgid = (int)L; { const int q = nwg / NXCD, r = nwg % NXCD, xcd = wgid % NXCD, off = wgid / NXCD; wgid = (xcd < r ? xcd * (q + 1) : r * (q + 1) + (xcd - r) * q) + off; }
        const int nig = WGM * nN, gid = wgid / nig, fm = gid * WGM, gsz = (nM - fm) < WGM ? (nM - fm) : WGM;
        u.pm = fm + ((wgid % nig) % gsz); u.pn = (wgid % nig) / gsz; return true;
    }
    __device__ __forceinline__ void a_ready(const Unit&) const {}
    __device__ __forceinline__ void done(const Unit&) const {}
};

typedef float f32x2cv __attribute__((ext_vector_type(2))); typedef __bf16 bf16x2cv __attribute__((ext_vector_type(2)));
__device__ __forceinline__ unsigned cvt_pk_bf16(float lo, float hi) { f32x2cv v = {lo, hi}; bf16x2cv b = __builtin_convertvector(v, bf16x2cv); return __builtin_bit_cast(unsigned, b); }
typedef float f32x2 __attribute__((ext_vector_type(2)));
typedef unsigned u32x2 __attribute__((ext_vector_type(2)));
__device__ __forceinline__ float sigm(float x) { return __builtin_amdgcn_rcpf(1.0f + __expf(-x)); }
__device__ __forceinline__ float bf_lo(unsigned w) { return __uint_as_float(w << 16); }
__device__ __forceinline__ float bf_hi(unsigned w) { return __uint_as_float(w & 0xffff0000u); }
__device__ __forceinline__ float rstd_row(const float* ssqp, int row) { const f32x4* p = (const f32x4*)(ssqp + (size_t)row * 16); const f32x4 a = p[0], b = p[1], c = p[2], d = p[3];
    const float s = ((a[0] + a[1]) + (a[2] + a[3])) + ((b[0] + b[1]) + (b[2] + b[3])) + ((c[0] + c[1]) + (c[2] + c[3])) + ((d[0] + d[1]) + (d[2] + d[3])); return rsqrtf(s * (1.0f / 1024.0f) + 1e-6f); }
#define EPI_FENCE() asm volatile("" ::: "memory")
__device__ __forceinline__ void rstd_fill(PG8_LAS float* rc, const float* ssq, int pm, int row0, int fr) {
    if (__float_as_int(rc[0]) != pm) {
#pragma unroll
        for (int ai = 0; ai < 2; ++ai)
#pragma unroll
            for (int m = 0; m < 4; ++m) rc[8 + ai * 64 + m * 16 + fr] = rstd_row(ssq, row0 + ai * HALF + m * 16);
        rc[0] = __int_as_float(pm);
    }
}
__device__ __forceinline__ unsigned q8(float g) { return (unsigned)(g * 255.0f + 0.5f); }
__device__ __forceinline__ unsigned q8x4(float a, float b, float c, float d) { return q8(a) | (q8(b) << 8) | (q8(c) << 16) | (q8(d) << 24); }
__device__ __forceinline__ float dq8(unsigned w, int k) { return (float)((w >> (8 * k)) & 0xffu) * (1.0f / 255.0f); }

struct PairOrder {
    StaticOrder base;
    __host__ __device__ void init(int M, int G_, int c_) { base.init(M, 1024, G_, c_); }
    __host__ __device__ bool next(int i, Unit& u) const { Unit b; if (!base.next(i >> 1, b)) return false; u.pm = b.pm; u.pn = 2 * b.pn + (i & 1); return true; }
    __device__ __forceinline__ void a_ready(const Unit&) const {}
    __device__ __forceinline__ void done(const Unit&) const {}
};

struct EpiIn {
    static constexpr bool PERM = true, AFTER_DRAIN = false;
    const float* ssq; const float* ropec; const float* ropes; const float* bgate;
    bf16_t *Q, *K, *V, *U, *G; float* S; PG8_LAS float* rcache;
    __device__ __forceinline__ void operator()(const f32x4 (&acc)[2][2][4][2], const Unit& u, int wr, int wc, int fr, int fq) const {
        const int row0 = u.pm * BM + wr * 64 + fr; const int pn = u.pn;
        PG8_LAS float* rc = rcache + (wr * 4 + wc) * 136; rstd_fill(rc, ssq, u.pm, row0, fr);
        if (pn < 3) {
            const bool ropelane = ((wc & 1) == 0) && (fq < 2);
            const float QS = 0.125f * 1.4426950408889634f;
#pragma unroll
            for (int ai = 0; ai < 2; ++ai)
#pragma unroll
                for (int m = 0; m < 4; ++m) {
                    const int row = row0 + ai * HALF + m * 16; const float rs = rc[8 + ai * 64 + m * 16 + fr];
                    const f32x4 cs = *(const f32x4*)(ropec + (size_t)row * 8 + 4 * (fq & 1)), sn = *(const f32x4*)(ropes + (size_t)row * 8 + 4 * (fq & 1));
#pragma unroll
                    for (int bj = 0; bj < 2; ++bj) {
                        f32x4 v0 = acc[ai][bj][m][0] * rs, v1 = acc[ai][bj][m][1] * rs;
                        bf16_t* dst; bool rope = ropelane; float sc = 1.f;
                        if (pn < 2) { dst = Q + (size_t)row * 512 + pn * 256 + bj * HALF + wc * 32 + 8 * fq; sc = QS; }
                        else if (bj == 0) { dst = K + (size_t)row * 128 + wc * 32 + 8 * fq; }
                        else { dst = V + (size_t)row * 128 + wc * 32 + 8 * fq; rope = false; }
                        if (rope) { const f32x4 o0 = v0 * cs - v1 * sn, o1 = v1 * cs + v0 * sn; v0 = o0; v1 = o1; }
                        v0 = v0 * sc; v1 = v1 * sc;
                        u32x4 w; w.x = cvt_pk_bf16(v0[0], v0[1]); w.y = cvt_pk_bf16(v0[2], v0[3]); w.z = cvt_pk_bf16(v1[0], v1[1]); w.w = cvt_pk_bf16(v1[2], v1[3]);
                        *(u32x4*)dst = w;
                    }
                    if (m == 3) EPI_FENCE();
                }
        } else if (pn == 3) {
#pragma unroll
            for (int ai = 0; ai < 2; ++ai)
#pragma unroll
                for (int m = 0; m < 4; ++m) {
                    const int row = row0 + ai * HALF + m * 16; const float rs = rc[8 + ai * 64 + m * 16 + fr];
#pragma unroll
                    for (int bj = 0; bj < 2; ++bj) { const f32x4 v0 = acc[ai][bj][m][0] * rs, v1 = acc[ai][bj][m][1] * rs;
                        u32x4 w; w.x = cvt_pk_bf16(v0[0], v0[1]); w.y = cvt_pk_bf16(v0[2], v0[3]); w.z = cvt_pk_bf16(v1[0], v1[1]); w.w = cvt_pk_bf16(v1[2], v1[3]);
                        *(u32x4*)((bf16_t*)S + (size_t)row * 256 + bj * HALF + wc * 32 + 8 * fq) = w; }
                    if (m == 3) EPI_FENCE();
                }
        } else if (pn < 6) {
#pragma unroll
            for (int ai = 0; ai < 2; ++ai)
#pragma unroll
                for (int m = 0; m < 4; ++m) {
                    const int row = row0 + ai * HALF + m * 16; const float rs = rc[8 + ai * 64 + m * 16 + fr];
#pragma unroll
                    for (int bj = 0; bj < 2; ++bj) {
                        const f32x4 a = acc[ai][bj][m][0] * rs, g = acc[ai][bj][m][1] * rs;
                        u32x2 w; w.x = cvt_pk_bf16(a[0] * sigm(g[0]), a[1] * sigm(g[1])); w.y = cvt_pk_bf16(a[2] * sigm(g[2]), a[3] * sigm(g[3]));
                        *(u32x2*)(U + (size_t)row * 256 + (pn - 4) * 128 + bj * 64 + wc * 16 + fq * 4) = w;
                    }
                    if (m == 3) EPI_FENCE();
                }
        } else {
            const int colb = (pn - 6) * 256 + wc * 32 + 8 * fq;
            f32x4 bv[2][2];
#pragma unroll
            for (int bj = 0; bj < 2; ++bj)
#pragma unroll
                for (int n = 0; n < 2; ++n) bv[bj][n] = *(const f32x4*)(bgate + colb + bj * HALF + 4 * n);
#pragma unroll
            for (int ai = 0; ai < 2; ++ai)
#pragma unroll
                for (int m = 0; m < 4; ++m) {
                    const int row = row0 + ai * HALF + m * 16; const float rs = rc[8 + ai * 64 + m * 16 + fr];
#pragma unroll
                    for (int bj = 0; bj < 2; ++bj) {
                        const f32x4 v0 = acc[ai][bj][m][0] * rs + bv[bj][0], v1 = acc[ai][bj][m][1] * rs + bv[bj][1];
#if defined(DBG_GATE_LIN)
                        u32x2 w; w.x = 0u; w.y = 0u;
#else
                        u32x2 w; w.x = q8x4(sigm(v0[0]), sigm(v0[1]), sigm(v0[2]), sigm(v0[3])); w.y = q8x4(sigm(v1[0]), sigm(v1[1]), sigm(v1[2]), sigm(v1[3]));
#endif
                        *(u32x2*)((unsigned char*)G + (size_t)row * 3072 + colb + bj * HALF) = w;
                    }
                    if (m == 3) EPI_FENCE();
                }
        }
    }
};

template <int MODE> struct EpiMerge {
    static constexpr bool PERM = true, AFTER_DRAIN = false;
    const bf16_t* G; bf16_t* MG;
    __device__ __forceinline__ void operator()(const f32x4 (&acc)[2][2][4][2], const Unit& u, int wr, int wc, int fr, int fq) const {
        const int row0 = u.pm * BM + wr * 64 + fr; const int col0 = u.pn * BM + wc * 32 + 8 * fq;
        u32x2 gwv[2][4][2];
#pragma unroll
        for (int ai = 0; ai < 2; ++ai)
#pragma unroll
            for (int m = 0; m < 4; ++m)
#pragma unroll
                for (int bj = 0; bj < 2; ++bj)
                    gwv[ai][m][bj] = *(const u32x2*)((const unsigned char*)G + (size_t)(row0 + ai * HALF + m * 16) * 3072 + (MODE == 0 ? 0 : 2048) + col0 + bj * HALF);
#pragma unroll
        for (int ai = 0; ai < 2; ++ai) {
            u32x4 pwv[4][2];
            if (MODE == 1) {
#pragma unroll
                for (int m = 0; m < 4; ++m)
#pragma unroll
                    for (int bj = 0; bj < 2; ++bj) pwv[m][bj] = *(const u32x4*)(MG + (size_t)(row0 + ai * HALF + m * 16) * 1024 + col0 + bj * HALF);
            }
            EPI_FENCE();
#pragma unroll
            for (int m = 0; m < 4; ++m) {
                const int row = row0 + ai * HALF + m * 16;
#pragma unroll
                for (int bj = 0; bj < 2; ++bj) {
                    const u32x2 gw = gwv[ai][m][bj];
                    bf16_t* mp = MG + (size_t)row * 1024 + col0 + bj * HALF;
                    const f32x4 a0 = acc[ai][bj][m][0], a1 = acc[ai][bj][m][1];
                    float o[8] = {dq8(gw.x, 0) * a0[0], dq8(gw.x, 1) * a0[1], dq8(gw.x, 2) * a0[2], dq8(gw.x, 3) * a0[3], dq8(gw.y, 0) * a1[0], dq8(gw.y, 1) * a1[1], dq8(gw.y, 2) * a1[2], dq8(gw.y, 3) * a1[3]};
                    if (MODE == 1) { const u32x4 pw = pwv[m][bj]; o[0] += bf_lo(pw.x); o[1] += bf_hi(pw.x); o[2] += bf_lo(pw.y); o[3] += bf_hi(pw.y); o[4] += bf_lo(pw.z); o[5] += bf_hi(pw.z); o[6] += bf_lo(pw.w); o[7] += bf_hi(pw.w); }
                    u32x4 w; w.x = cvt_pk_bf16(o[0], o[1]); w.y = cvt_pk_bf16(o[2], o[3]); w.z = cvt_pk_bf16(o[4], o[5]); w.w = cvt_pk_bf16(o[6], o[7]);
                    *(u32x4*)mp = w;
                }
            }
            EPI_FENCE();
        }
    }
};
struct EpiGlu {
    static constexpr bool PERM = true, AFTER_DRAIN = false;
    const bf16_t* G; bf16_t* MG; const float* bias;
    __device__ __forceinline__ void operator()(const f32x4 (&acc)[2][2][4][2], const Unit& u, int wr, int wc, int fr, int fq) const {
        const int row0 = u.pm * BM + wr * 64 + fr; const int dc0 = u.pn * 128 + wc * 16 + fq * 4;
        f32x4 ba[2], bb[2];
#pragma unroll
        for (int bj = 0; bj < 2; ++bj) { ba[bj] = *(const f32x4*)(bias + dc0 + bj * 64); bb[bj] = *(const f32x4*)(bias + 1024 + dc0 + bj * 64); }
        unsigned gwv[2][4][2]; u32x2 pwv[2][4][2];
#pragma unroll
        for (int ai = 0; ai < 2; ++ai)
#pragma unroll
            for (int m = 0; m < 4; ++m)
#pragma unroll
                for (int bj = 0; bj < 2; ++bj) { const int row = row0 + ai * HALF + m * 16;
                    gwv[ai][m][bj] = *(const unsigned*)((const unsigned char*)G + (size_t)row * 3072 + 1024 + dc0 + bj * 64);
                    pwv[ai][m][bj] = *(const u32x2*)(MG + (size_t)row * 1024 + dc0 + bj * 64); }
        EPI_FENCE();
#pragma unroll
        for (int ai = 0; ai < 2; ++ai)
#pragma unroll
            for (int m = 0; m < 4; ++m) {
                const int row = row0 + ai * HALF + m * 16;
#pragma unroll
                for (int bj = 0; bj < 2; ++bj) {
                    const unsigned gw = gwv[ai][m][bj]; const u32x2 pw = pwv[ai][m][bj];
                    bf16_t* mp = MG + (size_t)row * 1024 + dc0 + bj * 64;
                    const f32x4 a = acc[ai][bj][m][0] + ba[bj], b = acc[ai][bj][m][1] + bb[bj];
                    const float o0 = bf_lo(pw.x) + dq8(gw, 0) * a[0] * sigm(b[0]), o1 = bf_hi(pw.x) + dq8(gw, 1) * a[1] * sigm(b[1]);
                    const float o2 = bf_lo(pw.y) + dq8(gw, 2) * a[2] * sigm(b[2]), o3 = bf_hi(pw.y) + dq8(gw, 3) * a[3] * sigm(b[3]);
                    u32x2 w; w.x = cvt_pk_bf16(o0, o1); w.y = cvt_pk_bf16(o2, o3); *(u32x2*)mp = w;
                }
            }
    }
};
struct EpiFfn {
    static constexpr bool PERM = true, AFTER_DRAIN = false;
    const float* ssq; bf16_t* H; PG8_LAS float* rcache;
    __device__ __forceinline__ void operator()(const f32x4 (&acc)[2][2][4][2], const Unit& u, int wr, int wc, int fr, int fq) const {
        const int row0 = u.pm * BM + wr * 64 + fr; const int hc0 = u.pn * 128 + wc * 16 + fq * 4;
        PG8_LAS float* rc = rcache + (wr * 4 + wc) * 136; rstd_fill(rc, ssq, u.pm, row0, fr);
#pragma unroll
        for (int ai = 0; ai < 2; ++ai)
#pragma unroll
            for (int m = 0; m < 4; ++m) {
                const int row = row0 + ai * HALF + m * 16; const float rs = rc[8 + ai * 64 + m * 16 + fr];
#pragma unroll
                for (int bj = 0; bj < 2; ++bj) {
                    const f32x4 g = acc[ai][bj][m][0] * rs, up = acc[ai][bj][m][1] * rs;
                    u32x2 w; w.x = cvt_pk_bf16(g[0] * sigm(g[0]) * up[0], g[1] * sigm(g[1]) * up[1]); w.y = cvt_pk_bf16(g[2] * sigm(g[2]) * up[2], g[3] * sigm(g[3]) * up[3]);
                    *(u32x2*)(H + (size_t)row * 2816 + hc0 + bj * 64) = w;
                }
                if (m == 3) EPI_FENCE();
            }
    }
};
struct EpiStore {
    static constexpr bool PERM = true, AFTER_DRAIN = false;
    bf16_t* O;
    __device__ __forceinline__ void operator()(const f32x4 (&acc)[2][2][4][2], const Unit& u, int wr, int wc, int fr, int fq) const {
        const int row0 = u.pm * BM + wr * 64 + fr; const int col0 = u.pn * BM + wc * 32 + 8 * fq;
#pragma unroll
        for (int ai = 0; ai < 2; ++ai)
#pragma unroll
            for (int m = 0; m < 4; ++m) {
                const int row = row0 + ai * HALF + m * 16;
#pragma unroll
                for (int bj = 0; bj < 2; ++bj) { const f32x4 v0 = acc[ai][bj][m][0], v1 = acc[ai][bj][m][1];
                    u32x4 w; w.x = cvt_pk_bf16(v0[0], v0[1]); w.y = cvt_pk_bf16(v0[2], v0[3]); w.z = cvt_pk_bf16(v1[0], v1[1]); w.w = cvt_pk_bf16(v1[2], v1[3]);
                    *(u32x4*)(O + (size_t)row * 1024 + col0 + bj * HALF) = w; }
            }
    }
};
template <int MODE> struct EpiRes {
    static constexpr bool PERM = true, AFTER_DRAIN = false;
    const bf16_t* xin; bf16_t* xout; float* ssq_out; const float* ssq_in; const bf16_t* E;
    __device__ __forceinline__ void operator()(const f32x4 (&acc)[2][2][4][2], const Unit& u, int wr, int wc, int fr, int fq) const {
        const int row0 = u.pm * BM + wr * 64 + fr; const int col0 = u.pn * BM + wc * 32 + 8 * fq;
#pragma unroll
        for (int ai = 0; ai < 2; ++ai)
#pragma unroll
            for (int m = 0; m < 4; ++m) {
                const int row = row0 + ai * HALF + m * 16; const size_t off = (size_t)row * 1024 + col0;
                float rs = 0.f; if (MODE == 1) rs = rstd_row(ssq_in, row);
                float s = 0.f;
#pragma unroll
                for (int bj = 0; bj < 2; ++bj) {
                    const size_t o2 = off + bj * HALF;
                    const u32x4 xw = *(const u32x4*)(xin + o2); const f32x4 a0 = acc[ai][bj][m][0], a1 = acc[ai][bj][m][1];
                    float v[8] = {bf_lo(xw.x), bf_hi(xw.x), bf_lo(xw.y), bf_hi(xw.y), bf_lo(xw.z), bf_hi(xw.z), bf_lo(xw.w), bf_hi(xw.w)};
                    if (MODE == 0) { v[0] += a0[0]; v[1] += a0[1]; v[2] += a0[2]; v[3] += a0[3]; v[4] += a1[0]; v[5] += a1[1]; v[6] += a1[2]; v[7] += a1[3]; }
                    else { const u32x4 ew = *(const u32x4*)(E + o2);
                        v[0] += sigm(a0[0] * rs) * bf_lo(ew.x); v[1] += sigm(a0[1] * rs) * bf_hi(ew.x); v[2] += sigm(a0[2] * rs) * bf_lo(ew.y); v[3] += sigm(a0[3] * rs) * bf_hi(ew.y);
                        v[4] += sigm(a1[0] * rs) * bf_lo(ew.z); v[5] += sigm(a1[1] * rs) * bf_hi(ew.z); v[6] += sigm(a1[2] * rs) * bf_lo(ew.w); v[7] += sigm(a1[3] * rs) * bf_hi(ew.w); }
                    u32x4 w; w.x = cvt_pk_bf16(v[0], v[1]); w.y = cvt_pk_bf16(v[2], v[3]); w.z = cvt_pk_bf16(v[4], v[5]); w.w = cvt_pk_bf16(v[6], v[7]);
                    *(u32x4*)(xout + o2) = w;
                    s += ((v[0] * v[0] + v[1] * v[1]) + (v[2] * v[2] + v[3] * v[3])) + ((v[4] * v[4] + v[5] * v[5]) + (v[6] * v[6] + v[7] * v[7]));
                }
                s += __shfl_xor(s, 16); s += __shfl_xor(s, 32);
                if (fq == 0) ssq_out[(size_t)row * 16 + u.pn * 4 + wc] = s;
                if (m == 3) EPI_FENCE();
            }
    }
};

struct EpiNull {
    static constexpr bool PERM = true, AFTER_DRAIN = false;
    float* sink;
    __device__ __forceinline__ void operator()(const f32x4 (&acc)[2][2][4][2], const Unit& u, int wr, int wc, int fr, int fq) const {
        float s = 0.f;
#pragma unroll
        for (int ai = 0; ai < 2; ++ai)
#pragma unroll
            for (int bj = 0; bj < 2; ++bj)
#pragma unroll
                for (int m = 0; m < 4; ++m)
#pragma unroll
                    for (int n = 0; n < 2; ++n) s += (acc[ai][bj][m][n][0] + acc[ai][bj][m][n][1]) + (acc[ai][bj][m][n][2] + acc[ai][bj][m][n][3]);
        if (s == 1.2345e-30f) sink[0] = 1.f;
    }
};
template <class Epi, class Sched, bool ALIGN_EPI = false, bool SP2 = false>
__device__ __forceinline__ void gemm_phase(PG8_LAS unsigned char* lds, const Gemm g, const Sched& S, const Epi& E) {
    int tid_ = threadIdx.x; asm volatile("" : "+v"(tid_));
    const int tid = tid_, wid = __builtin_amdgcn_readfirstlane(tid >> 6), lane = tid & 63, wr = wid >> 2, wc = wid & 3, fr = lane & 15, fq = lane >> 4;
    int K_ = g.K; asm volatile("" : "+s"(K_));
    const int K = K_, nt = K / BK;
    unsigned voffA[2], voffB[2];
#pragma unroll
    for (int i = 0; i < 2; ++i) { int R, C; stage_rc(tid * 16 + i * 8192, R, C); const int Rb = Epi::PERM ? ((R & ~31) + perm32(R & 31)) : R;
        voffA[i] = (unsigned)(R * K + C) * 2u; voffB[i] = (unsigned)(Rb * K + C) * 2u; }
    const size_t kstep = (size_t)(BK * 2);
    const size_t hstep = (size_t)HALF * K * 2;
    const size_t tstep = 2 * hstep;
    const unsigned ldsw = (unsigned)wid * 1024u;
    const int aoff = lds_byte(wr * 64 + fr, fq * 8), boff = lds_byte(wc * 32 + fr, fq * 8);
#define PG8_SA(b, h) (((b) * 2 + (h)) * HTB)
#define PG8_SB(b, h) ((4 + (b) * 2 + (h)) * HTB)
#define PG8_STAGE(bufoff, gbase, voff) do { _Pragma("unroll") for (int _i = 0; _i < 2; ++_i) \
        __builtin_amdgcn_global_load_lds((const unsigned*)((const char*)(gbase) + (voff)[_i]), (PG8_LAS unsigned*)(lds + (bufoff) + ldsw + _i * 8192), 16, 0, 0); } while (0)
#define PG8_LDA(dst, b, h) do { _Pragma("unroll") for (int m = 0; m < 4; ++m) _Pragma("unroll") for (int k = 0; k < 2; ++k) dst[m][k] = *(const PG8_LAS bf16x8*)(lds + PG8_SA(b, h) + aoff + m * 2048 + k * 1024); } while (0)
#define PG8_LDB(dst, b, h) do { _Pragma("unroll") for (int n = 0; n < 2; ++n) _Pragma("unroll") for (int k = 0; k < 2; ++k) dst[n][k] = *(const PG8_LAS bf16x8*)(lds + PG8_SB(b, h) + boff + n * 2048 + k * 1024); } while (0)
#define PG8_MMA(ai, bj, At, Bt) do { __builtin_amdgcn_s_setprio(1); _Pragma("unroll") for (int m = 0; m < 4; ++m) _Pragma("unroll") for (int n = 0; n < 2; ++n) _Pragma("unroll") for (int k = 0; k < 2; ++k) \
        acc[ai][bj][m][n] = __builtin_amdgcn_mfma_f32_16x16x32_bf16(Bt[n][k], At[m][k], acc[ai][bj][m][n], 0, 0, 0); __builtin_amdgcn_s_setprio(0); } while (0)
#define PG8_WAIT_V(n) asm volatile("s_waitcnt vmcnt(" #n ")" ::: "memory")
#define PG8_WAIT_L(n) asm volatile("s_waitcnt lgkmcnt(" #n ")" ::: "memory")
#define PG8_BAR __builtin_amdgcn_s_barrier()
#define PG8_SCHED __builtin_amdgcn_sched_barrier(0)
    Unit cur, nxt; int ui = 0;
    if (!S.next(0, cur)) return;
    f32x4 acc[2][2][4][2];
#pragma unroll
    for (int a = 0; a < 2; ++a)
#pragma unroll
        for (int b = 0; b < 2; ++b)
#pragma unroll
            for (int m = 0; m < 4; ++m)
#pragma unroll
                for (int n = 0; n < 2; ++n) acc[a][b][m][n] = (f32x4){0.f, 0.f, 0.f, 0.f};
    bf16x8 At[4][2], B0[2][2], B1[2][2];
    const char* cA = (const char*)g.A + (size_t)cur.pm * tstep; const char* cB = (const char*)g.Bt + (size_t)cur.pn * tstep;
    S.a_ready(cur);
    if constexpr (SP2) {
        PG8_STAGE(PG8_SB(0, 0), cB, voffB); PG8_STAGE(PG8_SB(0, 1), cB + hstep, voffB); PG8_STAGE(PG8_SA(0, 0), cA, voffA); PG8_STAGE(PG8_SA(0, 1), cA + hstep, voffA);
        if (wr == 1) PG8_BAR;
        PG8_WAIT_V(2); PG8_BAR;
        PG8_STAGE(PG8_SB(1, 0), cB + kstep, voffB); PG8_STAGE(PG8_SA(1, 0), cA + kstep, voffA); PG8_STAGE(PG8_SB(1, 1), cB + hstep + kstep, voffB);
        PG8_WAIT_V(6); PG8_BAR;
    } else {
        PG8_STAGE(PG8_SB(0, 0), cB, voffB); PG8_STAGE(PG8_SA(0, 0), cA, voffA); PG8_STAGE(PG8_SB(0, 1), cB + hstep, voffB); PG8_STAGE(PG8_SA(0, 1), cA + hstep, voffA);
        if (wr == 1) PG8_BAR;
        PG8_WAIT_V(4); PG8_BAR;
        PG8_STAGE(PG8_SB(1, 0), cB + kstep, voffB); PG8_STAGE(PG8_SA(1, 0), cA + kstep, voffA); PG8_STAGE(PG8_SB(1, 1), cB + hstep + kstep, voffB);
        PG8_WAIT_V(6); PG8_BAR;
    }
    for (;;) {
        const bool has_next = S.next(ui + 1, nxt);
        const char* nA = has_next ? (const char*)g.A + (size_t)nxt.pm * tstep : cA; const char* nB = has_next ? (const char*)g.Bt + (size_t)nxt.pn * tstep : cB;
        for (int t = 0; t < nt; t += 2) {
            const bool last = (t == nt - 2);
            const char* a1 = cA + (size_t)(t + 1) * kstep;
            const char* a2 = last ? nA : cA + (size_t)(t + 2) * kstep; const char* b2 = last ? nB : cB + (size_t)(t + 2) * kstep;
            const char* a3 = a2 + kstep; const char* b3 = b2 + kstep;
            if (last && has_next) S.a_ready(nxt);
            if constexpr (SP2) {
            PG8_LDB(B0, 0, 0); PG8_LDB(B1, 0, 1); PG8_SCHED; PG8_LDA(At, 0, 0); PG8_STAGE(PG8_SA(1, 1), a1 + hstep, voffA);
            PG8_WAIT_V(8); PG8_WAIT_L(0); PG8_BAR; PG8_MMA(0, 0, At, B0); PG8_MMA(0, 1, At, B1); PG8_BAR; PG8_SCHED;
            PG8_LDA(At, 0, 1); PG8_STAGE(PG8_SB(0, 0), b2, voffB); PG8_STAGE(PG8_SB(0, 1), b2 + hstep, voffB); PG8_STAGE(PG8_SA(0, 0), a2, voffA);
            PG8_WAIT_V(8); PG8_WAIT_L(0); PG8_BAR; PG8_MMA(1, 0, At, B0); PG8_MMA(1, 1, At, B1); PG8_BAR; PG8_SCHED;
            PG8_LDB(B0, 1, 0); PG8_LDB(B1, 1, 1); PG8_SCHED; PG8_LDA(At, 1, 0); PG8_STAGE(PG8_SA(0, 1), a2 + hstep, voffA);
            PG8_WAIT_V(8); PG8_WAIT_L(0); PG8_BAR; PG8_MMA(0, 0, At, B0); PG8_MMA(0, 1, At, B1); PG8_BAR; PG8_SCHED;
            PG8_LDA(At, 1, 1); PG8_STAGE(PG8_SB(1, 0), b3, voffB); PG8_STAGE(PG8_SB(1, 1), b3 + hstep, voffB); PG8_STAGE(PG8_SA(1, 0), a3, voffA);
            PG8_WAIT_V(8); PG8_WAIT_L(0); PG8_BAR; PG8_MMA(1, 0, At, B0); PG8_MMA(1, 1, At, B1); PG8_BAR; PG8_SCHED;
            } else {
            PG8_LDB(B0, 0, 0); PG8_SCHED; PG8_LDA(At, 0, 0); PG8_STAGE(PG8_SA(1, 1), a1 + hstep, voffA);
            PG8_WAIT_L(8); PG8_BAR; PG8_WAIT_L(0); PG8_MMA(0, 0, At, B0); PG8_BAR; PG8_SCHED;
            PG8_LDB(B1, 0, 1); PG8_STAGE(PG8_SB(0, 0), b2, voffB);
            PG8_BAR; PG8_WAIT_L(0); PG8_MMA(0, 1, At, B1); PG8_BAR;
            PG8_LDA(At, 0, 1); PG8_STAGE(PG8_SA(0, 0), a2, voffA);
            PG8_BAR; PG8_WAIT_L(0); PG8_MMA(1, 0, At, B0); PG8_BAR; PG8_SCHED;
            PG8_STAGE(PG8_SB(0, 1), b2 + hstep, voffB);
            PG8_WAIT_V(6); PG8_BAR; PG8_MMA(1, 1, At, B1); PG8_BAR;
            PG8_LDB(B0, 1, 0); PG8_SCHED; PG8_LDA(At, 1, 0); PG8_STAGE(PG8_SA(0, 1), a2 + hstep, voffA);
            PG8_WAIT_L(8); PG8_BAR; PG8_WAIT_L(0); PG8_MMA(0, 0, At, B0); PG8_BAR; PG8_SCHED;
            PG8_LDB(B1, 1, 1); PG8_STAGE(PG8_SB(1, 0), b3, voffB);
            PG8_BAR; PG8_WAIT_L(0); PG8_MMA(0, 1, At, B1); PG8_BAR;
            PG8_LDA(At, 1, 1); PG8_STAGE(PG8_SA(1, 0), a3, voffA);
            PG8_BAR; PG8_WAIT_L(0); PG8_MMA(1, 0, At, B0); PG8_BAR; PG8_SCHED;
            PG8_STAGE(PG8_SB(1, 1), b3 + hstep, voffB);
            PG8_WAIT_V(6); PG8_BAR; PG8_MMA(1, 1, At, B1); PG8_BAR;
            }
        }
        if constexpr (ALIGN_EPI) { if (wr == 0) PG8_BAR; }
        if constexpr (!Epi::AFTER_DRAIN) { E(acc, cur, wr, wc, fr, fq); S.done(cur); }
        if (!has_next) break;
#pragma unroll
        for (int a = 0; a < 2; ++a)
#pragma unroll
            for (int b = 0; b < 2; ++b)
#pragma unroll
                for (int m = 0; m < 4; ++m)
#pragma unroll
                    for (int n = 0; n < 2; ++n) acc[a][b][m][n] = (f32x4){0.f, 0.f, 0.f, 0.f};
        cur = nxt; cA = nA; cB = nB; ++ui;
        if constexpr (ALIGN_EPI) { if (wr == 1) PG8_BAR; }
    }
    PG8_WAIT_V(0);
    if constexpr (!ALIGN_EPI) { if (wr == 0) PG8_BAR; }
    PG8_BAR;
    if constexpr (Epi::AFTER_DRAIN) { E.fused(acc, cur, wr, wc, fr, fq, lds, wid, lane); S.done(cur); }
#undef PG8_SA
#undef PG8_SB
#undef PG8_STAGE
#undef PG8_LDA
#undef PG8_LDB
#undef PG8_MMA
#undef PG8_WAIT_V
#undef PG8_WAIT_L
#undef PG8_BAR
#undef PG8_SCHED
}
}

#define LAS __attribute__((address_space(3)))
typedef unsigned short bf16;
typedef unsigned u32x4 __attribute__((ext_vector_type(4)));
typedef unsigned u32x2 __attribute__((ext_vector_type(2)));
typedef float f32x4 __attribute__((ext_vector_type(4)));
typedef float f32x16 __attribute__((ext_vector_type(16)));
typedef short bf16x8 __attribute__((ext_vector_type(8)));
constexpr int M = 65536, D = 1024, SEQ = 4096, NIN = 4608, FF = 2816, DEPTH = 4;
constexpr size_t MiB = 1u << 20;
constexpr size_t WS_SSQ = 1 * MiB, WS_ROPE = 13 * MiB, WS_CARRY = 17 * MiB, WS_W = 26 * MiB, WS_XB = 156 * MiB, WS_ACT = 284 * MiB, WS_END = 988 * MiB;
constexpr size_t WO_IN = 0, WO_AO = WO_IN + (size_t)4608 * 1024, WO_GLU = WO_AO + (size_t)1024 * 512, WO_CO = WO_GLU + (size_t)2048 * 256, WO_MIX = WO_CO + (size_t)1024 * 256,
                 WO_FI = WO_MIX + (size_t)1024 * 1024, WO_FO = WO_FI + (size_t)5632 * 1024, WO_PI = WO_FO + (size_t)1024 * 2816, WO_PG = WO_PI + (size_t)1024 * 256, W_LAYER = WO_PG + (size_t)1024 * 1024;
static_assert(W_LAYER * 2 * DEPTH <= 130 * MiB, "weights fit");
constexpr size_t A_Q = 0, A_K = 64 * MiB, A_V = 80 * MiB, A_S = 96 * MiB, A_U = 160 * MiB, A_G = 192 * MiB, A_AO = 576 * MiB, A_YS = 640 * MiB, A_YC = 672 * MiB;
constexpr size_t A_MG = 0, A_HID = 0, A_E = 384 * MiB, A_PB = 576 * MiB;
static_assert((size_t)M * FF * 2 <= 384 * MiB, "hidden fits under E");
constexpr int LDS_BYTES = 147456, RING_BYTES = 131072;

#ifndef DBG_LAYERS
#define DBG_LAYERS DEPTH
#endif
#ifndef DBG_MASK
#define DBG_MASK 0xffffffffu
#endif
#ifndef DBG_USE_XB
#define DBG_USE_XB 0
#endif
#ifndef DBG_REP
#define DBG_REP 0u
#endif
#define REPS(bit) for (int rep_ = 0; rep_ < ((DBG_REP & (bit)) ? 2 : 1); ++rep_)
#ifndef DBG_MASK1
#define DBG_MASK1 DBG_MASK
#endif
struct Args { const void* in[31]; float* out; unsigned char* ws; float inv_freq[8]; unsigned mask; unsigned mask1; int ph_lo; int ph_hi; };
constexpr int NPH = 2 + 8 * DBG_LAYERS;

__device__ __forceinline__ float wave_sum(float v) {
#pragma unroll
    for (int o = 1; o < 64; o <<= 1) v += __shfl_xor(v, o);
    return v;
}
__device__ __forceinline__ unsigned pk2(float lo, float hi) { return pg8::cvt_pk_bf16(lo, hi); }
__device__ __forceinline__ float bflo(unsigned w) { return __uint_as_float(w << 16); }
__device__ __forceinline__ float bfhi(unsigned w) { return __uint_as_float(w & 0xffff0000u); }
__device__ __forceinline__ float sigm_(float x) { return __builtin_amdgcn_rcpf(1.0f + __expf(-x)); }
__device__ __forceinline__ int crow(int r, int hi) { return (r & 3) + 8 * (r >> 2) + 4 * hi; }

__device__ __forceinline__ int colmap(int mode, int np) {
    if (mode == 1) {
        if (np < 640) { const int hd = np & 63, base = np & ~63; int s = hd; if (hd < 16) { const int i = hd & 3, blk = hd >> 2; s = ((blk & 1) ? 8 : 0) + ((blk >> 1) ? 4 : 0) + i; } return base + s; }
        if (np < 1024) return np;
        if (np < 1536) { const int q = np - 1024, i = q >> 3, j = q & 7; return (j < 4) ? 1024 + 4 * i + j : 1280 + 4 * i + (j - 4); }
        return np;
    }
    if (mode == 2) { const int i = np >> 3, j = np & 7; return (j < 4) ? 4 * i + j : 2816 + 4 * i + (j - 4); }
    if (mode == 3) { const int i = np >> 3, j = np & 7; return (j < 4) ? 4 * i + j : 1024 + 4 * i + (j - 4); }
    return np;
}
__device__ __forceinline__ void cvt_item(const float* W, int K, int N, int mode, const float* gain, bf16* WT, LAS float* scr, int item, int lane) {
    const int nblk = N / 32, kb = item / nblk, nb = item % nblk, k0 = 64 * kb, n0 = 32 * nb;
    const int sc = colmap(mode, n0 + (lane & 31));
#pragma unroll 8
    for (int i = 0; i < 32; ++i) { const int kk = 2 * i + (lane >> 5); float v = W[(size_t)(k0 + kk) * N + sc]; if (gain) v *= gain[k0 + kk]; scr[kk * 33 + (lane & 31)] = v; }
    asm volatile("s_waitcnt lgkmcnt(0)" ::: "memory");
    const int c = lane & 7;
#pragma unroll
    for (int j = 0; j < 4; ++j) { const int n = (lane >> 3) + 8 * j; const LAS float* s = scr + (8 * c) * 33 + n;
        u32x4 o; o.x = pk2(s[0 * 33], s[1 * 33]); o.y = pk2(s[2 * 33], s[3 * 33]); o.z = pk2(s[4 * 33], s[5 * 33]); o.w = pk2(s[6 * 33], s[7 * 33]);
        *(u32x4*)(WT + (size_t)(n0 + n) * K + k0 + 8 * c) = o; }
    asm volatile("s_waitcnt lgkmcnt(0)" ::: "memory");
}

__device__ __forceinline__ void attn_phase(LAS unsigned char* lds, const bf16* Q, const bf16* K, const bf16* V, bf16* AO, const float* sinks, int vcu, int G, int tid, int wid, int lane) {
    LAS unsigned char* Ks = lds;
    LAS unsigned short* Vt = (LAS unsigned short*)(lds + 36864);
    const int r32 = lane & 31, hi = lane >> 5;
    for (int unit = vcu; unit < 1024; unit += G) {
        const int b = unit >> 6, blk = (unit >> 1) & 31, kvh = unit & 1;
        const long band0 = (long)b * SEQ + blk * 128 - 128;
#pragma unroll
        for (int i = 0; i < 4; ++i) {
            const int c = tid + 512 * i, row = c >> 3, part = c & 7;
            u32x4 kv = (u32x4){0u, 0u, 0u, 0u}, vv = (u32x4){0u, 0u, 0u, 0u};
            if (blk > 0 || row >= 128) { kv = *(const u32x4*)(K + (band0 + row) * 128 + kvh * 64 + part * 8); vv = *(const u32x4*)(V + (band0 + row) * 128 + kvh * 64 + part * 8); }
            *(LAS u32x4*)(Ks + row * 144 + part * 16) = kv;
            LAS unsigned short* vp = Vt + (part * 8) * 264 + row;
            vp[0 * 264] = (unsigned short)(vv.x & 0xffffu); vp[1 * 264] = (unsigned short)(vv.x >> 16);
            vp[2 * 264] = (unsigned short)(vv.y & 0xffffu); vp[3 * 264] = (unsigned short)(vv.y >> 16);
            vp[4 * 264] = (unsigned short)(vv.z & 0xffffu); vp[5 * 264] = (unsigned short)(vv.z >> 16);
            vp[6 * 264] = (unsigned short)(vv.w & 0xffffu); vp[7 * 264] = (unsigned short)(vv.w >> 16);
        }
        __syncthreads();
        for (int it = 0; it < 2; ++it) {
            const int task = wid * 2 + it, g = task >> 2, j = task & 3, head = kvh * 4 + g;
            const long qrow = (long)b * SEQ + blk * 128 + 32 * j;
            bf16x8 qf[4];
#pragma unroll
            for (int d0 = 0; d0 < 4; ++d0) qf[d0] = *(const bf16x8*)(Q + (qrow + r32) * 512 + head * 64 + d0 * 16 + hi * 8);
            f32x16 p[5];
#pragma unroll
            for (int tt = 0; tt < 5; ++tt) {
#pragma unroll
                for (int r = 0; r < 16; ++r) p[tt][r] = 0.f;
#pragma unroll
                for (int d0 = 0; d0 < 4; ++d0) { const bf16x8 kf = *(const LAS bf16x8*)(Ks + (32 * (j + tt) + r32) * 144 + d0 * 32 + hi * 16); p[tt] = __builtin_amdgcn_mfma_f32_32x32x16_bf16(kf, qf[d0], p[tt], 0, 0, 0); }
            }
            const float sink2 = sinks[head] * 1.4426950408889634f;
            float mx = sink2;
#pragma unroll
            for (int tt = 0; tt < 5; ++tt)
#pragma unroll
                for (int r = 0; r < 16; ++r) { const int dd = 32 * tt + crow(r, hi) - r32, kj = 32 * (j + tt) + crow(r, hi); const bool ok = (dd >= 1) && (dd <= 128) && (blk > 0 || kj >= 128);
                    p[tt][r] = ok ? p[tt][r] : -1e30f; mx = fmaxf(mx, p[tt][r]); }
            mx = fmaxf(mx, __shfl_xor(mx, 32));
            float sum = 0.f;
#pragma unroll
            for (int tt = 0; tt < 5; ++tt)
#pragma unroll
                for (int r = 0; r < 16; ++r) { p[tt][r] = __builtin_amdgcn_exp2f(p[tt][r] - mx); sum += p[tt][r]; }
            sum += __shfl_xor(sum, 32);
            const float inv = 1.0f / (sum + __builtin_amdgcn_exp2f(sink2 - mx));
            f32x16 o[2];
#pragma unroll
            for (int r = 0; r < 16; ++r) { o[0][r] = 0.f; o[1][r] = 0.f; }
#pragma unroll
            for (int tt = 0; tt < 5; ++tt)
#pragma unroll
                for (int h2 = 0; h2 < 2; ++h2) {
                    u32x4 pw; pw.x = pk2(p[tt][8 * h2 + 0] * inv, p[tt][8 * h2 + 1] * inv); pw.y = pk2(p[tt][8 * h2 + 2] * inv, p[tt][8 * h2 + 3] * inv);
                    pw.z = pk2(p[tt][8 * h2 + 4] * inv, p[tt][8 * h2 + 5] * inv); pw.w = pk2(p[tt][8 * h2 + 6] * inv, p[tt][8 * h2 + 7] * inv);
                    const bf16x8 pa = __builtin_bit_cast(bf16x8, pw);
                    const int kvb = 32 * (j + tt) + 16 * h2;
#pragma unroll
                    for (int dh = 0; dh < 2; ++dh) {
                        const LAS unsigned short* vb = Vt + (32 * dh + r32) * 264 + kvb + 4 * hi;
                        const u32x2 lo = *(const LAS u32x2*)vb, hi2 = *(const LAS u32x2*)(vb + 8);
                        const u32x4 vw = (u32x4){lo.x, lo.y, hi2.x, hi2.y};
                        o[dh] = __builtin_amdgcn_mfma_f32_32x32x16_bf16(pa, __builtin_bit_cast(bf16x8, vw), o[dh], 0, 0, 0);
                    }
                }
#pragma unroll
            for (int dh = 0; dh < 2; ++dh)
#pragma unroll
                for (int r = 0; r < 16; r += 2) {
                    const unsigned w = pk2(o[dh][r], o[dh][r + 1]);
                    AO[(qrow + crow(r, hi)) * 512 + head * 64 + 32 * dh + r32] = (bf16)(w & 0xffffu);
                    AO[(qrow + crow(r + 1, hi)) * 512 + head * 64 + 32 * dh + r32] = (bf16)(w >> 16);
                }
        }
        __syncthreads();
    }
}

__device__ __forceinline__ void conv_phase(LAS unsigned char* lds, const bf16* U, bf16* YC, const float* dww, const float* dwb, const float* lng, const float* lnb, int vcu, int G, int tid, int wid, int lane) {
    LAS unsigned* Us = (LAS unsigned*)lds;
    LAS float* Cs = (LAS float*)(lds + 49152);
    const int c2 = tid & 127, tg = tid >> 7;
    float w0[31], w1[31];
#pragma unroll
    for (int j = 0; j < 31; ++j) { w0[j] = dww[j * 256 + 2 * c2]; w1[j] = dww[j * 256 + 2 * c2 + 1]; }
    const float b0 = dwb[2 * c2], b1 = dwb[2 * c2 + 1];
    const f32x4 gg = *(const f32x4*)(lng + 4 * lane), gb = *(const f32x4*)(lnb + 4 * lane);
    for (int tile = vcu; tile < 1024; tile += G) {
        const long t0 = (long)tile * 64; const int s0 = (tile & 63) * 64;
        for (int c = tid; c < 94 * 32; c += 512) { const int row = c >> 5, part = c & 31; u32x4 v = (u32x4){0u, 0u, 0u, 0u};
            if (s0 + row - 30 >= 0) v = *(const u32x4*)(U + (t0 + row - 30) * 256 + part * 8);
            *(LAS u32x4*)(lds + row * 512 + part * 16) = v; }
        __syncthreads();
        float a0[16], a1[16];
#pragma unroll
        for (int i = 0; i < 16; ++i) { a0[i] = b0; a1[i] = b1; }
#pragma unroll
        for (int r = 0; r < 46; ++r) { const unsigned uw = Us[(16 * tg + r) * 128 + c2]; const float u0 = bflo(uw), u1 = bfhi(uw);
#pragma unroll
            for (int i = 0; i < 16; ++i) { const int j = r - i; if (j >= 0 && j <= 30) { a0[i] += w0[j] * u0; a1[i] += w1[j] * u1; } } }
#pragma unroll
        for (int i = 0; i < 16; ++i) { LAS float* cp = Cs + (16 * tg + i) * 260 + 2 * c2; cp[0] = a0[i]; cp[1] = a1[i]; }
        __syncthreads();
#pragma unroll
        for (int k = 0; k < 8; ++k) { const int tok = 8 * wid + k; f32x4 v = *(const LAS f32x4*)(Cs + tok * 260 + 4 * lane);
            const float mean = wave_sum((v[0] + v[1]) + (v[2] + v[3])) * (1.0f / 256.0f); v = v - mean;
            const float var = wave_sum((v[0] * v[0] + v[1] * v[1]) + (v[2] * v[2] + v[3] * v[3])) * (1.0f / 256.0f); const float rstd = rsqrtf(var + 1e-6f);
            v = v * rstd * gg + gb;
            u32x2 w; w.x = pk2(v[0] * sigm_(v[0]), v[1] * sigm_(v[1])); w.y = pk2(v[2] * sigm_(v[2]), v[3] * sigm_(v[3]));
            *(u32x2*)(YC + (t0 + tok) * 256 + 4 * lane) = w; }
        __syncthreads();
    }
}

struct SsmCoef { float ar, ai; float br[16], bi[16]; };
__device__ __forceinline__ void ssm_coef(SsmCoef& c, const float* lam_re, const float* lam_im, const float* log_dt, const float* b_re, const float* b_im, int g, int n) {
    const float lr = fminf(lam_re[g * 64 + n], -1e-4f), li = lam_im[g * 64 + n], dt = expf(log_dt[g]);
    const float mag = expf(lr * dt); float sn, cs; sincosf(li * dt, &sn, &cs);
    c.ar = mag * cs; c.ai = mag * sn;
    const float den = lr * lr + li * li, xr = c.ar - 1.0f, xi = c.ai;
    const float fr = (xr * lr + xi * li) / den, fi = (xi * lr - xr * li) / den;
    const f32x4* pr = (const f32x4*)(b_re + (size_t)(g * 64 + n) * 16); const f32x4* pi = (const f32x4*)(b_im + (size_t)(g * 64 + n) * 16);
#pragma unroll
    for (int q = 0; q < 4; ++q) { const f32x4 r = pr[q], i = pi[q];
#pragma unroll
        for (int e = 0; e < 4; ++e) { c.br[4 * q + e] = fr * r[e] - fi * i[e]; c.bi[4 * q + e] = fr * i[e] + fi * r[e]; } }
}
__device__ __forceinline__ void ssm_stage_u(LAS float* us, const float* SIN, long row0, int g, int lane) {
    const bf16* S16 = (const bf16*)SIN;
#pragma unroll
    for (int i = 0; i < 2; ++i) { const int ch = lane + 64 * i, row = ch >> 1, hf = ch & 1; const u32x4 w = *(const u32x4*)(S16 + (row0 + row) * 256 + g * 16 + hf * 8);
        *(LAS f32x4*)(us + row * 16 + hf * 8) = (f32x4){bflo(w.x), bfhi(w.x), bflo(w.y), bfhi(w.y)}; *(LAS f32x4*)(us + row * 16 + hf * 8 + 4) = (f32x4){bflo(w.z), bfhi(w.z), bflo(w.w), bfhi(w.w)}; }
}
__device__ __forceinline__ void ssm_step(const SsmCoef& c, const LAS float* ut, float& sr, float& si) {
    const f32x4 u0 = *(const LAS f32x4*)(ut), u1 = *(const LAS f32x4*)(ut + 4), u2 = *(const LAS f32x4*)(ut + 8), u3 = *(const LAS f32x4*)(ut + 12);
    float br = 0.f, bi = 0.f;
#pragma unroll
    for (int e = 0; e < 4; ++e) { br += u0[e] * c.br[e]; bi += u0[e] * c.bi[e]; }
#pragma unroll
    for (int e = 0; e < 4; ++e) { br += u1[e] * c.br[4 + e]; bi += u1[e] * c.bi[4 + e]; }
#pragma unroll
    for (int e = 0; e < 4; ++e) { br += u2[e] * c.br[8 + e]; bi += u2[e] * c.bi[8 + e]; }
#pragma unroll
    for (int e = 0; e < 4; ++e) { br += u3[e] * c.br[12 + e]; bi += u3[e] * c.bi[12 + e]; }
    const float nr = c.ar * sr - c.ai * si + br, ni = c.ar * si + c.ai * sr + bi; sr = nr; si = ni;
}
constexpr size_t WS_COEF = 128 * 1024; constexpr int COEF_DW = 1280;
__device__ __forceinline__ void ssm_table(unsigned* tab, const float* lam_re, const float* lam_im, const float* log_dt, const float* b_re, const float* b_im, int g, int lane) {
    SsmCoef cf; ssm_coef(cf, lam_re, lam_im, log_dt, b_re, b_im, g, lane);
#pragma unroll
    for (int comp = 0; comp < 2; ++comp)
#pragma unroll
        for (int h2 = 0; h2 < 2; ++h2) { const int ct = (lane >> 5) * 2 + comp, cl = h2 * 32 + (lane & 31);
            u32x4 w;
            if (comp == 0) { w.x = pk2(cf.br[8 * h2 + 0], cf.br[8 * h2 + 1]); w.y = pk2(cf.br[8 * h2 + 2], cf.br[8 * h2 + 3]); w.z = pk2(cf.br[8 * h2 + 4], cf.br[8 * h2 + 5]); w.w = pk2(cf.br[8 * h2 + 6], cf.br[8 * h2 + 7]); }
            else           { w.x = pk2(cf.bi[8 * h2 + 0], cf.bi[8 * h2 + 1]); w.y = pk2(cf.bi[8 * h2 + 2], cf.bi[8 * h2 + 3]); w.z = pk2(cf.bi[8 * h2 + 4], cf.bi[8 * h2 + 5]); w.w = pk2(cf.bi[8 * h2 + 6], cf.bi[8 * h2 + 7]); }
            *(u32x4*)(tab + (ct * 64 + cl) * 4) = w; }
    float pr = cf.ar, pi = cf.ai;
#pragma unroll
    for (int q = 0; q < 6; ++q) { const float nr = pr * pr - pi * pi, ni = 2.0f * pr * pi; pr = nr; pi = ni; }
    float* tf = (float*)tab; tf[1024 + lane] = cf.ar; tf[1088 + lane] = cf.ai; tf[1152 + lane] = pr; tf[1216 + lane] = pi;
}
__device__ __forceinline__ void ssm_bu_tile(const LAS float* us32, LAS unsigned char* T, const bf16x8 (&bfr)[4], int r32, int hi) {
    const f32x4 ua = *(const LAS f32x4*)(us32 + r32 * 16 + 8 * hi), ub = *(const LAS f32x4*)(us32 + r32 * 16 + 8 * hi + 4);
    u32x4 aw; aw.x = pk2(ua[0], ua[1]); aw.y = pk2(ua[2], ua[3]); aw.z = pk2(ub[0], ub[1]); aw.w = pk2(ub[2], ub[3]);
    const bf16x8 af = __builtin_bit_cast(bf16x8, aw);
    f32x16 z;
#pragma unroll
    for (int r = 0; r < 16; ++r) z[r] = 0.f;
    const f32x16 d0 = __builtin_amdgcn_mfma_f32_32x32x16_bf16(af, bfr[0], z, 0, 0, 0), d1 = __builtin_amdgcn_mfma_f32_32x32x16_bf16(af, bfr[1], z, 0, 0, 0);
    const f32x16 d2 = __builtin_amdgcn_mfma_f32_32x32x16_bf16(af, bfr[2], z, 0, 0, 0), d3 = __builtin_amdgcn_mfma_f32_32x32x16_bf16(af, bfr[3], z, 0, 0, 0);
#pragma unroll
    for (int r = 0; r < 16; ++r) { LAS unsigned char* tp = T + crow(r, hi) * 272 + r32 * 4; *(LAS unsigned*)tp = pk2(d0[r], d1[r]); *(LAS unsigned*)(tp + 128) = pk2(d2[r], d3[r]); }
}
__device__ __forceinline__ void ssm_s1(LAS unsigned char* lds, const float* SIN, float* CARRY, const unsigned* coef, int vcu, int G, int wid, int lane) {
    LAS float* us = (LAS float*)(lds + wid * 12800);
    LAS unsigned char* T = lds + wid * 12800 + 4096;
    const int r32 = lane & 31, hi = lane >> 5;
    for (int task = vcu * 8 + wid; task < 16384; task += G * 8) {
        const int c = task >> 4, g = task & 15;
        const unsigned* tab = coef + (size_t)g * COEF_DW;
        bf16x8 bfr[4];
#pragma unroll
        for (int ct = 0; ct < 4; ++ct) bfr[ct] = __builtin_bit_cast(bf16x8, *(const u32x4*)(tab + (ct * 64 + lane) * 4));
        const float ar = ((const float*)tab)[1024 + lane], ai = ((const float*)tab)[1088 + lane];
        ssm_stage_u(us, SIN, (long)c * 64, g, lane);
        float sr = 0.f, si = 0.f;
#pragma unroll 1
        for (int half = 0; half < 2; ++half) {
            ssm_bu_tile(us + half * 512, T, bfr, r32, hi);
#pragma unroll 8
            for (int t = 0; t < 32; ++t) { const unsigned w = *(const LAS unsigned*)(T + t * 272 + lane * 4); const float nr = ar * sr - ai * si + bflo(w), ni = ar * si + ai * sr + bfhi(w); sr = nr; si = ni; }
        }
        *(float2*)(CARRY + ((size_t)(c * 16 + g) * 64 + lane) * 2) = make_float2(sr, si);
    }
}
__device__ __forceinline__ float gelu_tanh(float x) { const float z = 0.7978845608028654f * (x + 0.044715f * x * x * x); const float t = 1.0f - 2.0f * __builtin_amdgcn_rcpf(1.0f + __expf(2.0f * z)); return 0.5f * x * (1.0f + t); }
__device__ __forceinline__ void ssm_s3(LAS unsigned char* lds, const float* SIN, const float* CARRY, bf16* YS, const unsigned* coef,
                                       const float* c_re, const float* c_im, const float* dsk, int vcu, int G, int wid, int lane) {
    LAS float* us = (LAS float*)(lds + wid * 12800);
    LAS unsigned char* St = lds + wid * 12800 + 4096;
    const int r32 = lane & 31, hi = lane >> 5;
    for (int task = vcu * 8 + wid; task < 16384; task += G * 8) {
        const int c0 = task >> 4, g = task & 15, b = c0 >> 6, cs = ((c0 & 63) + 9 * (task >> 11)) & 63, c = b * 64 + cs;
        const unsigned* tab = coef + (size_t)g * COEF_DW;
        bf16x8 bfr[4];
#pragma unroll
        for (int ct = 0; ct < 4; ++ct) bfr[ct] = __builtin_bit_cast(bf16x8, *(const u32x4*)(tab + (ct * 64 + lane) * 4));
        const float ar = ((const float*)tab)[1024 + lane], ai = ((const float*)tab)[1088 + lane];
        bf16x8 ccf[8];
#pragma unroll
        for (int kk = 0; kk < 8; ++kk) { f32x4 cr = (f32x4){0.f, 0.f, 0.f, 0.f}, ci = cr;
            if (r32 < 16) { cr = *(const f32x4*)(c_re + (size_t)(g * 16 + r32) * 64 + 8 * kk + 4 * hi); ci = *(const f32x4*)(c_im + (size_t)(g * 16 + r32) * 64 + 8 * kk + 4 * hi); }
            u32x4 w; w.x = pk2(cr[0], -ci[0]); w.y = pk2(cr[1], -ci[1]); w.z = pk2(cr[2], -ci[2]); w.w = pk2(cr[3], -ci[3]); ccf[kk] = __builtin_bit_cast(bf16x8, w); }
        const float dk = (r32 < 16) ? dsk[g * 16 + r32] : 0.f;
        const float pr = ((const float*)tab)[1152 + lane], pi = ((const float*)tab)[1216 + lane];
        float sr = 0.f, si = 0.f;
        { const float* cb = CARRY + ((size_t)(b * 64 * 16 + g) * 64 + lane) * 2; int cp = 0;
          for (; cp + 8 <= cs; cp += 8) { float2 f[8];
#pragma unroll
              for (int k = 0; k < 8; ++k) f[k] = *(const float2*)(cb + (size_t)(cp + k) * 2048);
#pragma unroll
              for (int k = 0; k < 8; ++k) { const float nr = pr * sr - pi * si + f[k].x, ni = pr * si + pi * sr + f[k].y; sr = nr; si = ni; } }
          for (; cp < cs; ++cp) { const float2 f = *(const float2*)(cb + (size_t)cp * 2048);
              const float nr = pr * sr - pi * si + f.x, ni = pr * si + pi * sr + f.y; sr = nr; si = ni; } }
        ssm_stage_u(us, SIN, (long)c * 64, g, lane);
#pragma unroll 1
        for (int half = 0; half < 2; ++half) {
            ssm_bu_tile(us + half * 512, St, bfr, r32, hi);
#pragma unroll 8
            for (int t = 0; t < 32; ++t) { LAS unsigned* tp = (LAS unsigned*)(St + t * 272 + lane * 4); const unsigned w = *tp; const float nr = ar * sr - ai * si + bflo(w), ni = ar * si + ai * sr + bfhi(w); sr = nr; si = ni; *tp = pk2(sr, si); }
            f32x16 y;
#pragma unroll
            for (int r = 0; r < 16; ++r) y[r] = 0.f;
#pragma unroll
            for (int kk = 0; kk < 8; ++kk) { const bf16x8 af = *(const LAS bf16x8*)(St + r32 * 272 + kk * 32 + hi * 16); y = __builtin_amdgcn_mfma_f32_32x32x16_bf16(af, ccf[kk], y, 0, 0, 0); }
            if (r32 < 16) {
#pragma unroll
                for (int r = 0; r < 16; ++r) { const int t = half * 32 + crow(r, hi); const float v = y[r] + dk * us[t * 16 + r32];
                    YS[((long)c * 64 + t) * 256 + g * 16 + r32] = (bf16)(pk2(gelu_tanh(v), 0.f) & 0xffffu); }
            }
        }
    }
}

#define XB_TMO      128
#define XB_XCNT(j)  (256  + 64 * (j))
#define XB_XSUB(j)  (1280 + 64 * (j))
#define XB_XGEN(j)  (2304 + 64 * (j))
#define XB_TOP      3328
#define XB_TOPGEN   3392
#define XCD_BAR_WORDS 3456
#define XB_SPIN_CAP (1u << 23)

__device__ __forceinline__ unsigned xb_ld(unsigned* p)              { return __hip_atomic_load(p, __ATOMIC_RELAXED, __HIP_MEMORY_SCOPE_AGENT); }
__device__ __forceinline__ unsigned xb_add(unsigned* p, unsigned v) { return __hip_atomic_fetch_add(p, v, __ATOMIC_RELAXED, __HIP_MEMORY_SCOPE_AGENT); }
__device__ __forceinline__ unsigned xb_xcc_id() { return (unsigned)__builtin_amdgcn_s_getreg((3 << 11) | 20) & 0xFu; }
#define XB_SPIN(cond, bar) do { unsigned _sp = 0; while (cond) { __builtin_amdgcn_s_sleep(1); \
    if ((++_sp & 255u) == 0u) { if (xb_ld(&(bar)[XB_TMO])) break; if (_sp > XB_SPIN_CAP) { atomicAdd(&(bar)[XB_TMO], 1u); break; } } } } while (0)

struct XcdBarrier {
    unsigned* bar; unsigned x;
    volatile LAS unsigned* st;
};

__device__ __forceinline__ XcdBarrier xcd_barrier_post(unsigned* bar, volatile LAS unsigned* st) {
    XcdBarrier b; b.bar = bar; b.x = xb_xcc_id(); b.st = st;
    if (threadIdx.x == 0) (void)xb_add(&bar[XB_XCNT(b.x)], 1u);
    return b;
}
__device__ __forceinline__ void xcd_barrier_complete(unsigned* bar, unsigned x, unsigned& nloc, unsigned& nx) {
    const unsigned G = gridDim.x * gridDim.y * gridDim.z;
    unsigned sum, cnt, mine, sp = 0u;
    for (;;) {
        sum = 0u; cnt = 0u; mine = 0u;
#pragma unroll
        for (unsigned j = 0; j < 16; ++j) { const unsigned c = xb_ld(&bar[XB_XCNT(j)]); sum += c; cnt += (c > 0u) ? 1u : 0u; mine = (j == x) ? c : mine; }
        if (sum == G) break;
        __builtin_amdgcn_s_sleep(1);
        if ((++sp & 255u) == 0u) { if (xb_ld(&bar[XB_TMO])) break; if (sp > XB_SPIN_CAP) { atomicAdd(&bar[XB_TMO], 1u); break; } }
    }
    nloc = mine > 0u ? mine : 1u; nx = cnt > 0u ? cnt : 1u;
}

__device__ __forceinline__ void xcd_barrier(const XcdBarrier& b) {
    asm volatile("s_waitcnt vmcnt(0)" ::: "memory");
    __syncthreads();
    if (threadIdx.x == 0) {
        unsigned* bar = b.bar; const unsigned bx_ = xb_xcc_id();
        __builtin_amdgcn_s_waitcnt(0);
        unsigned nloc = b.st[0], nx = b.st[1];
        if (nloc == 0u) { xcd_barrier_complete(bar, bx_, nloc, nx); b.st[0] = nloc; b.st[1] = nx; }
        const unsigned old = xb_add(&bar[XB_XSUB(bx_)], 1u);
        const unsigned gen = old / nloc;
        if (old + 1u == (gen + 1u) * nloc) {
            __builtin_amdgcn_fence(__ATOMIC_RELEASE, "agent");
            asm volatile("s_waitcnt vmcnt(0)" ::: "memory");
            const unsigned og = xb_add(&bar[XB_TOP], 1u);
            const unsigned tg = og / nx;
            if (og + 1u == (tg + 1u) * nx) xb_add(&bar[XB_TOPGEN], 1u);
            else XB_SPIN(xb_ld(&bar[XB_TOPGEN]) == tg, bar);
            __builtin_amdgcn_fence(__ATOMIC_ACQUIRE, "agent");
            xb_add(&bar[XB_XGEN(bx_)], 1u);
            asm volatile("s_waitcnt vmcnt(0)" ::: "memory");
        } else {
            XB_SPIN(xb_ld(&bar[XB_XGEN(bx_)]) == gen, bar);
            __builtin_amdgcn_fence(__ATOMIC_ACQUIRE, "agent");
            asm volatile("s_waitcnt vmcnt(0)" ::: "memory");
        }
    }
    __syncthreads();
}

#define GRID_SYNC() xcd_barrier(xbar)
__device__ __forceinline__ const void* karg(int idx) { const __attribute__((address_space(1))) char* p; const void* kp = (const void*)__builtin_amdgcn_kernarg_segment_ptr(); asm volatile("s_load_dwordx2 %0, %1, %2\n\ts_waitcnt lgkmcnt(0)" : "=s"(p) : "s"(kp), "i"(idx * 8)); return (const void*)p; }
__global__ void __launch_bounds__(512, 2) mega_fwd(Args a) {
    extern __shared__ __attribute__((aligned(16))) unsigned char lds_raw[];
    LAS unsigned char* lds = (LAS unsigned char*)lds_raw;
    cg::grid_group grid = cg::this_grid();
    if (threadIdx.x < 64) ((volatile LAS unsigned*)(lds + RING_BYTES))[threadIdx.x] = 0u;
    __syncthreads();
    XcdBarrier xbar = xcd_barrier_post((unsigned*)a.ws, (volatile LAS unsigned*)(lds + RING_BYTES) + 8);
    if (a.ph_lo == 0 && a.ph_hi == NPH) grid.sync();
    const int tid = threadIdx.x, lane = tid & 63, wid = __builtin_amdgcn_readfirstlane(tid >> 6);
    const int G = gridDim.x, bx = blockIdx.x, vcu = (G % 8 == 0) ? (bx % 8) * (G / 8) + bx / 8 : bx;
    unsigned char* ws = a.ws;
    float* SSQA = (float*)(ws + WS_SSQ); float* SSQB = SSQA + (size_t)M * 16; float* SSQC = SSQB + (size_t)M * 16; float* ROPEC = (float*)(ws + WS_ROPE); float* ROPES = ROPEC + (size_t)M * 8; float* CARRY = (float*)(ws + WS_CARRY); unsigned* COEF = (unsigned*)(ws + WS_COEF);
    bf16* WB = (bf16*)(ws + WS_W); bf16* XB = (bf16*)(ws + WS_XB); unsigned char* ACT = ws + WS_ACT;
    bf16* Qb = (bf16*)(ACT + A_Q); bf16* Kb = (bf16*)(ACT + A_K); bf16* Vb = (bf16*)(ACT + A_V); float* Sb = (float*)(ACT + A_S); bf16* Ub = (bf16*)(ACT + A_U); bf16* Gb = (bf16*)(ACT + A_G);
    bf16* AOb = (bf16*)(ACT + A_AO); bf16* YSb = (bf16*)(ACT + A_YS); bf16* YCb = (bf16*)(ACT + A_YC); bf16* MGb = (bf16*)(ACT + A_MG); bf16* HIDb = (bf16*)(ACT + A_HID); bf16* Eb = (bf16*)(ACT + A_E); bf16* PBb = (bf16*)(ACT + A_PB); bf16* XBR = (bf16*)a.out;
    const float* x_in = (const float*)karg(0);
    const int gw = vcu * 8 + wid, NGW = G * 8;

    int ph = 0; unsigned pmask = 0u;
#define IN_RANGE() (ph >= a.ph_lo && ph < a.ph_hi)
#if defined(DBG_BAR2)
#define XBAR2() xcd_barrier(xbar)
#else
#define XBAR2() do {} while (0)
#endif
#define NEXT_PHASE(bm) do { if (ph >= a.ph_lo && ph + 1 < a.ph_hi) { xcd_barrier(xbar); XBAR2(); } ++ph; pmask = IN_RANGE() ? (bm) : 0u; } while (0)
    REPS(0x10000u) if (IN_RANGE()) {
        for (int i = bx * 512 + tid; i < M * 8; i += G * 512) { const int row = i >> 3, k = i & 7; const float ang = (float)((const int*)karg(2))[row] * a.inv_freq[k]; float sn, cs; sincosf(ang, &sn, &cs); ROPEC[i] = cs; ROPES[i] = sn; }
        for (int m = gw; m < M; m += NGW) { const f32x4* xr = (const f32x4*)(x_in + (size_t)m * D) + lane; u32x2* o = (u32x2*)(XBR + (size_t)m * D) + lane; float s = 0.f;
#pragma unroll
            for (int j = 0; j < 4; ++j) { const f32x4 v = xr[64 * j]; s += (v[0] * v[0] + v[1] * v[1]) + (v[2] * v[2] + v[3] * v[3]); u32x2 w; w.x = pk2(v[0], v[1]); w.y = pk2(v[2], v[3]); o[64 * j] = w; }
            s = wave_sum(s); if (lane < 16) SSQC[(size_t)m * 16 + lane] = (lane == 0) ? s : 0.f; }
        if (gw < DEPTH * 16) { const int Lt = gw >> 4, gt = gw & 15; ssm_table(COEF + (size_t)gw * COEF_DW, (const float*)karg(8) + Lt * 1024, (const float*)karg(9) + Lt * 1024, (const float*)karg(10) + Lt * 16, (const float*)karg(11) + (size_t)Lt * 16384, (const float*)karg(12) + (size_t)Lt * 16384, gt, lane); }
        LAS float* scr = (LAS float*)(lds + wid * 16384);
        constexpr int I_IN = 16 * 144, I_AO = 8 * 32, I_GLU = 4 * 64, I_CO = 4 * 32, I_MIX = 16 * 32, I_FI = 16 * 176, I_FO = 44 * 32, I_PI = 4 * 32, I_PG = 16 * 32;
        constexpr int I_LAYER = I_IN + I_AO + I_GLU + I_CO + I_MIX + I_FI + I_FO + I_PI + I_PG;
        for (int it = gw; it < I_LAYER * DEPTH; it += NGW) {
            const int L = it / I_LAYER; int r = it % I_LAYER; bf16* wl = WB + (size_t)L * W_LAYER;
            if (r < I_IN) { cvt_item((const float*)karg(4) + (size_t)L * 1024 * 4608, 1024, 4608, 1, (const float*)karg(3) + L * 1024, wl + WO_IN, scr, r, lane); continue; } r -= I_IN;
            if (r < I_AO) { cvt_item((const float*)karg(7) + (size_t)L * 512 * 1024, 512, 1024, 0, nullptr, wl + WO_AO, scr, r, lane); continue; } r -= I_AO;
            if (r < I_GLU) { cvt_item((const float*)karg(16) + (size_t)L * 256 * 2048, 256, 2048, 3, nullptr, wl + WO_GLU, scr, r, lane); continue; } r -= I_GLU;
            if (r < I_CO) { cvt_item((const float*)karg(22) + (size_t)L * 256 * 1024, 256, 1024, 0, nullptr, wl + WO_CO, scr, r, lane); continue; } r -= I_CO;
            if (r < I_MIX) { cvt_item((const float*)karg(23) + (size_t)L * 1024 * 1024, 1024, 1024, 0, nullptr, wl + WO_MIX, scr, r, lane); continue; } r -= I_MIX;
            if (r < I_FI) { cvt_item((const float*)karg(25) + (size_t)L * 1024 * 5632, 1024, 5632, 2, (const float*)karg(24) + L * 1024, wl + WO_FI, scr, r, lane); continue; } r -= I_FI;
            if (r < I_FO) { cvt_item((const float*)karg(26) + (size_t)L * 2816 * 1024, 2816, 1024, 0, nullptr, wl + WO_FO, scr, r, lane); continue; } r -= I_FO;
            if (r < I_PI) { cvt_item((const float*)karg(27) + (size_t)L * 256 * 1024, 256, 1024, 0, nullptr, wl + WO_PI, scr, r, lane); continue; } r -= I_PI;
            cvt_item((const float*)karg(29) + (size_t)L * 1024 * 1024, 1024, 1024, 0, (const float*)karg(28) + L * 1024, wl + WO_PG, scr, r, lane);
        }
    }
    NEXT_PHASE(a.mask);

#ifndef STAG_SCALE
#define STAG_SCALE 0
#endif
#define STAGGER(n) do { if ((bx >> 3) & 1) { for (int s_ = 0; s_ < (n) * STAG_SCALE; ++s_) __builtin_amdgcn_s_sleep(127); } } while (0)
#define FRESH_IDS() int tid2 = threadIdx.x; asm volatile("" : "+v"(tid2)); const int lane2 = tid2 & 63, wid2 = __builtin_amdgcn_readfirstlane(tid2 >> 6)
#pragma unroll 1
    for (int L = 0; L < DBG_LAYERS; ++L) {
        const bf16* wl = WB + (size_t)L * W_LAYER;
        const bf16* xcur = XBR;
        bf16* xnext = (L == DBG_LAYERS - 1) ? MGb : XBR;
        const unsigned bmask = (L == 0) ? a.mask : a.mask1; pmask = IN_RANGE() ? bmask : 0u;
#ifndef SKIP_P1
        REPS(1u) if (pmask & 1u)
        {
            if (lane == 0) ((LAS float*)(lds + RING_BYTES + 1024))[wid * 136] = __int_as_float(-1);
            STAGGER(2); pg8::Gemm g{xcur, wl + WO_IN, M, NIN, D};   pg8::StaticOrder S; S.init(M, NIN, G, bx);
            pg8::EpiIn E{SSQC, ROPEC, ROPES, (const float*)karg(5) + L * 3072, Qb, Kb, Vb, Ub, Gb, Sb, (LAS float*)(lds + RING_BYTES + 1024)};
            pg8::gemm_phase<pg8::EpiIn, pg8::StaticOrder, true, true>(lds, g, S, E);
        }
#endif
        NEXT_PHASE(bmask);
#ifndef SKIP_ATTN
        REPS(2u) if (pmask & 2u) { FRESH_IDS();
        attn_phase(lds, Qb, Kb, Vb, AOb, (const float*)karg(6) + L * 8, vcu, G, tid2, wid2, lane2); }
#endif
#ifndef SKIP_CONV
        REPS(4u) if (pmask & 4u) { FRESH_IDS();
        conv_phase(lds, Ub, YCb, (const float*)karg(18) + L * 31 * 256, (const float*)karg(19) + L * 256, (const float*)karg(20) + L * 256, (const float*)karg(21) + L * 256, vcu, G, tid2, wid2, lane2); }
#endif
#ifndef SKIP_S1
        REPS(8u) if (pmask & 8u) { FRESH_IDS();
        ssm_s1(lds, Sb, CARRY, COEF + (size_t)L * 16 * COEF_DW, vcu, G, wid2, lane2); }
#endif
        NEXT_PHASE(bmask);
#ifndef SKIP_S3
        REPS(16u) if (pmask & 16u) { FRESH_IDS();
        ssm_s3(lds, Sb, CARRY, YSb, COEF + (size_t)L * 16 * COEF_DW,
               (const float*)karg(13) + (size_t)L * 16384, (const float*)karg(14) + (size_t)L * 16384, (const float*)karg(15) + L * 256, vcu, G, wid2, lane2); }
#endif
        NEXT_PHASE(bmask);
#ifndef SKIP_P3
        REPS(32u) {
            if (pmask & 32u) { STAGGER(3); pg8::Gemm g{AOb, wl + WO_AO, M, D, 512}; pg8::StaticOrder S; S.init(M, D, G, bx); pg8::EpiMerge<0> E{Gb, MGb};
              pg8::gemm_phase<pg8::EpiMerge<0>, pg8::StaticOrder, true, true>(lds, g, S, E); }
            asm volatile("s_waitcnt vmcnt(0)" ::: "memory"); __syncthreads();
            if (pmask & 64u) { pg8::Gemm g{YCb, wl + WO_CO, M, D, 256}; pg8::StaticOrder S; S.init(M, D, G, bx); pg8::EpiMerge<1> E{Gb, MGb};
              pg8::gemm_phase<pg8::EpiMerge<1>, pg8::StaticOrder, true, true>(lds, g, S, E); }
            asm volatile("s_waitcnt vmcnt(0)" ::: "memory"); __syncthreads();
            if (pmask & 128u) { pg8::Gemm g{YSb, wl + WO_GLU, M, 2048, 256}; pg8::PairOrder S; S.init(M, G, bx); pg8::EpiGlu E{Gb, MGb, (const float*)karg(17) + L * 2048};
              pg8::gemm_phase<pg8::EpiGlu, pg8::PairOrder, true, true>(lds, g, S, E); }
        }
#endif
        NEXT_PHASE(bmask);
#ifndef SKIP_P4
        REPS(256u) if (pmask & 256u)
        {
#if defined(DBG_DRY) && DBG_DRY == 1
            { pg8::Gemm g{MGb, wl + WO_MIX, M, D, D}; pg8::StaticOrder S; S.init(M, D, G, bx); pg8::EpiNull E{(float*)CARRY}; pg8::gemm_phase<pg8::EpiNull, pg8::StaticOrder, true, true>(lds, g, S, E); }
#endif
            STAGGER(3); pg8::Gemm g{MGb, wl + WO_MIX, M, D, D}; pg8::StaticOrder S; S.init(M, D, G, bx);
            pg8::EpiRes<0> E{xcur, XB, SSQA, nullptr, nullptr};
            pg8::gemm_phase<pg8::EpiRes<0>, pg8::StaticOrder, true, true>(lds, g, S, E);
        }
#endif
        NEXT_PHASE(bmask);
#ifndef SKIP_P5
        REPS(512u) if (pmask & 512u)
        {
            const f32x4* ps = (const f32x4*)((const float*)karg(1) + (size_t)L * M * 256);
            FRESH_IDS(); (void)lane2; (void)wid2;
            for (int i = bx * 512 + tid2; i < M * 256 / 8; i += G * 512) { const f32x4 v0 = ps[2 * (size_t)i], v1 = ps[2 * (size_t)i + 1];
                u32x4 w; w.x = pk2(v0[0], v0[1]); w.y = pk2(v0[2], v0[3]); w.z = pk2(v1[0], v1[1]); w.w = pk2(v1[2], v1[3]); ((u32x4*)PBb)[i] = w; }
            if (lane == 0) ((LAS float*)(lds + RING_BYTES + 1024))[wid * 136] = __int_as_float(-1);
            STAGGER(2); pg8::Gemm g{XB, wl + WO_FI, M, 2 * FF, D}; pg8::StaticOrder S; S.init(M, 2 * FF, G, bx);
            pg8::EpiFfn E{SSQA, HIDb, (LAS float*)(lds + RING_BYTES + 1024)};
            pg8::gemm_phase<pg8::EpiFfn, pg8::StaticOrder, true, true>(lds, g, S, E);
        }
#endif
        NEXT_PHASE(bmask);
#ifndef SKIP_P6
        {
#if defined(DBG_DRY)
            { pg8::Gemm g{HIDb, wl + WO_FO, M, D, FF}; pg8::StaticOrder S; S.init(M, D, G, bx); pg8::EpiNull E{(float*)CARRY}; pg8::gemm_phase<pg8::EpiNull, pg8::StaticOrder, true, true>(lds, g, S, E); }
#endif
            if (pmask & 1024u) { STAGGER(5); pg8::Gemm g{HIDb, wl + WO_FO, M, D, FF}; pg8::StaticOrder S; S.init(M, D, G, bx);
              pg8::EpiRes<0> E{XB, XB, SSQB, nullptr, nullptr};
              pg8::gemm_phase<pg8::EpiRes<0>, pg8::StaticOrder, true, true>(lds, g, S, E); }
            REPS(2048u) if (pmask & 2048u) { pg8::Gemm g{PBb, wl + WO_PI, M, D, 256}; pg8::StaticOrder S; S.init(M, D, G, bx); pg8::EpiStore E{Eb};
              pg8::gemm_phase<pg8::EpiStore, pg8::StaticOrder, true, true>(lds, g, S, E); }
        }
#endif
        NEXT_PHASE(bmask);
#ifndef SKIP_P7
        REPS(4096u) if (pmask & 4096u)
        {
#if defined(DBG_DRY) && DBG_DRY == 1
            { pg8::Gemm g{XB, wl + WO_PG, M, D, D}; pg8::StaticOrder S; S.init(M, D, G, bx); pg8::EpiNull E{(float*)CARRY}; pg8::gemm_phase<pg8::EpiNull, pg8::StaticOrder, true, true>(lds, g, S, E); }
#endif
            STAGGER(3); pg8::Gemm g{XB, wl + WO_PG, M, D, D}; pg8::StaticOrder S; S.init(M, D, G, bx);
            pg8::EpiRes<1> E{XB, xnext, SSQC, SSQB, Eb};
            pg8::gemm_phase<pg8::EpiRes<1>, pg8::StaticOrder, true, true>(lds, g, S, E);
        }
#endif
        NEXT_PHASE(bmask);
    }
#if defined(DBG_DUMP)
    if (IN_RANGE()) {
        FRESH_IDS(); (void)lane2; (void)wid2;
        const size_t n = (size_t)M * D;
        for (size_t i = (size_t)bx * 512 + tid2; i < n; i += (size_t)G * 512) {
            float v = 0.f;
#if DBG_DUMP == 1
            if (i < (size_t)M * 512) v = bflo((unsigned)Qb[i]); else if (i < (size_t)M * 640) v = bflo((unsigned)Kb[i - (size_t)M * 512]); else if (i < (size_t)M * 768) v = bflo((unsigned)Vb[i - (size_t)M * 640]); else v = Sb[i - (size_t)M * 768];
#elif DBG_DUMP == 2
            if (i < (size_t)M * 512) v = bflo((unsigned)AOb[i]); else if (i < (size_t)M * 768) v = bflo((unsigned)YCb[i - (size_t)M * 512]); else v = bflo((unsigned)YSb[i - (size_t)M * 768]);
#elif DBG_DUMP == 3
            v = bflo((unsigned)MGb[i]);
#elif DBG_DUMP == 6
            if (i < n / 2) v = bflo((unsigned)XBR[i]); else v = SSQC[(size_t)((i - n / 2) >> 9) * 16];
#elif DBG_DUMP == 7
            if (i < 3 * W_LAYER) v = bflo((unsigned)WB[W_LAYER + i]); else v = 0.f;
#elif DBG_DUMP == 8
            if (i < (size_t)M * 256) v = Sb[i]; else v = 0.f;
#elif DBG_DUMP == 9
            if (i < (size_t)M * 8) v = ROPEC[i]; else if (i < (size_t)M * 16) v = ROPES[i - (size_t)M * 8]; else if (i < (size_t)M * 32) v = SSQC[i - (size_t)M * 16]; else if (i < (size_t)M * 544) v = bflo((unsigned)XBR[(size_t)M * 512 + (i - (size_t)M * 32)]); else v = 0.f;
#elif DBG_DUMP == 10
            if (i < (size_t)M * 16) v = SSQC[i]; else v = 0.f;
#elif DBG_DUMP == 11
            if (i < (size_t)M * 512) v = bflo((unsigned)XBR[(size_t)M * 512 + i]); else v = 0.f;
#elif DBG_DUMP == 5
            if (i < (size_t)M * 256) v = bflo((unsigned)Ub[i]); else if (i < (size_t)M * 768) v = bflo((unsigned)Gb[(i - (size_t)M * 256) / 512 * 3072 + (i % 512)]); else v = 0.f;
#endif
            a.out[i] = v;
        }
    }
#elif defined(DBG_NOFINAL)
#else
    if (IN_RANGE()) {
        FRESH_IDS(); (void)tid2; const int lane = lane2, gw = vcu * 8 + wid2;
        const float* fg = (const float*)karg(30); const float* ssqf = SSQC;
        for (int m = gw; m < M; m += NGW) { const u32x2* xs = (const u32x2*)(MGb + (size_t)m * D) + lane; f32x4* xr = (f32x4*)(a.out + (size_t)m * D) + lane; const float rs = pg8::rstd_row(ssqf, m);
#pragma unroll
            for (int j = 0; j < 4; ++j) { const f32x4 gv = ((const f32x4*)fg)[lane + 64 * j]; const u32x2 w = xs[64 * j]; const f32x4 xv = (f32x4){bflo(w.x), bfhi(w.x), bflo(w.y), bfhi(w.y)}; xr[64 * j] = xv * rs * gv; } }
    }
#endif
}

extern "C" void kernel_launch(void* const* d_in, const int* in_sizes, int n_in, void* d_out, int out_size, void* d_ws, size_t ws_size, hipStream_t stream) {
    static int grid = 0;
    if (grid == 0) {
        if (n_in != 31 || in_sizes[0] != M * D || out_size != M * D || ws_size < WS_END) { fprintf(stderr, "kernel_launch: unexpected shapes: n_in %d in0 %d out %d ws %zu (need %zu)\n", n_in, n_in > 0 ? in_sizes[0] : -1, out_size, ws_size, (size_t)WS_END); grid = -1; return; }
        int dev = 0, cus = 0, per_cu = 0;
        hipGetDevice(&dev); hipDeviceGetAttribute(&cus, hipDeviceAttributeMultiprocessorCount, dev);
        if (hipFuncSetAttribute((const void*)mega_fwd, hipFuncAttributeMaxDynamicSharedMemorySize, LDS_BYTES) != hipSuccess) { fprintf(stderr, "kernel_launch: hipFuncSetAttribute failed\n"); grid = -1; return; }
        if (hipOccupancyMaxActiveBlocksPerMultiprocessor(&per_cu, (const void*)mega_fwd, 512, LDS_BYTES) != hipSuccess || per_cu < 1) { fprintf(stderr, "kernel_launch: occupancy query says %d\n", per_cu); per_cu = 1; }
        (void)hipGetLastError();
        grid = cus;
        if (grid > 256) grid = 256;
    }
    if (grid < 0) return;
    Args a{};
    for (int i = 0; i < 31; ++i) a.in[i] = d_in[i];
    a.out = (float*)d_out; a.ws = (unsigned char*)d_ws;
    for (int i = 0; i < 8; ++i) a.inv_freq[i] = (float)pow(500000.0, -(double)i / 8.0);
    a.mask = DBG_MASK; a.mask1 = DBG_MASK1;
#if defined(DBG_POISON)
    (void)hipMemsetAsync(d_ws, 0xAA, WS_END, stream); (void)hipMemsetAsync(d_out, 0xAA, (size_t)out_size * 4, stream);
#endif
    if (hipMemsetAsync(d_ws, 0, 65536, stream) != hipSuccess) { fprintf(stderr, "kernel_launch: memset failed\n"); return; }
#if defined(MK_MULTI)
    for (int ph = 0; ph < NPH; ++ph) { a.ph_lo = ph; a.ph_hi = ph + 1; hipLaunchKernelGGL(mega_fwd, dim3(grid), dim3(512), LDS_BYTES, stream, a); }
#else
    a.ph_lo = 0; a.ph_hi = NPH;
    void* args[] = {&a};
    hipError_t e = hipLaunchCooperativeKernel((const void*)mega_fwd, dim3(grid), dim3(512), args, LDS_BYTES, stream);
    if (e != hipSuccess) fprintf(stderr, "kernel_launch: cooperative launch failed: %s (grid %d)\n", hipGetErrorString(e), grid);
#endif
}
```

```cpp
#include <hip/hip_runtime.h>
#include <hip/hip_cooperative_groups.h>
#include <cstdio>
#include <cstdint>
#include <cmath>
namespace cg = cooperative_groups;
namespace pg8 {
#define PG8_LAS __attribute__((address_space(3)))
typedef unsigned short bf16_t;
typedef short bf16x8 __attribute__((ext_vector_type(8)));
typedef float f32x4 __attribute__((ext_vector_type(4)));
typedef unsigned u32x4 __attribute__((ext_vector_type(4)));
constexpr int BM = 256, BK = 64, HALF = 128, HTB = HALF * BK * 2  , STAGE_BYTES = 8 * HTB, NXCD = 8, WGM = 8;

__host__ __device__ __forceinline__ int lds_byte(int r, int c) { const int st = (r >> 4) * 2 + (c >> 5), rr = r & 15, cc = c & 31, ob = rr * 64 + cc * 2; return st * 1024 + (ob ^ (((ob >> 9) & 1) << 5)); }
__host__ __device__ __forceinline__ void stage_rc(int b, int& R, int& C) { const int st = b / 1024, sb = b % 1024, swz = sb ^ (((sb >> 9) & 1) << 5); R = (st >> 1) * 16 + swz / 64; C = (st & 1) * 32 + (swz % 64) / 2; }
__host__ __device__ __forceinline__ int perm32(int rho) { const int n = rho >> 4, i = rho & 15; return 8 * (i >> 2) + 4 * n + (i & 3); }

struct Unit { int pm, pn; };
struct Gemm { const bf16_t* A; const bf16_t* Bt; int M, N, K; };

struct StaticOrder {
    int nM, nN, nwg, G, c;
    __host__ __device__ void init(int M, int N, int G_, int c_) { nM = M / BM; nN = N / BM; nwg = nM * nN; G = G_; c = c_; }
    __host__ __device__ bool next(int i, Unit& u) const {
        const long L = (long)i * G + c; if (L >= nwg) return false;
        int wgid = (int)L; { const int q = nwg / NXCD, r = nwg % NXCD, xcd = wgid % NXCD, off = wgid / NXCD; wgid = (xcd < r ? xcd * (q + 1) : r * (q + 1) + (xcd - r) * q) + off; }
        const int nig = WGM * nN, gid = wgid / nig, fm = gid * WGM, gsz = (nM - fm) < WGM ? (nM - fm) : WGM;
        u.pm = fm + ((wgid % nig) % gsz); u.pn = (wgid % nig) / gsz; return true;
    }
    __device__ __forceinline__ void a_ready(const Unit&) const {}
    __device__ __forceinline__ void done(const Unit&) const {}
};

typedef float f32x2cv __attribute__((ext_vector_type(2))); typedef __bf16 bf16x2cv __attribute__((ext_vector_type(2)));
__device__ __forceinline__ unsigned cvt_pk_bf16(float lo, float hi) { f32x2cv v = {lo, hi}; bf16x2cv b = __builtin_convertvector(v, bf16x2cv); return __builtin_bit_cast(unsigned, b); }
typedef float f32x2 __attribute__((ext_vector_type(2)));
typedef unsigned u32x2 __attribute__((ext_vector_type(2)));
__device__ __forceinline__ float sigm(float x) { return __builtin_amdgcn_rcpf(1.0f + __expf(-x)); }
__device__ __forceinline__ float bf_lo(unsigned w) { return __uint_as_float(w << 16); }
__device__ __forceinline__ float bf_hi(unsigned w) { return __uint_as_float(w & 0xffff0000u); }
__device__ __forceinline__ float rstd_row(const float* ssqp, int row) { const f32x4* p = (const f32x4*)(ssqp + (size_t)row * 16); const f32x4 a = p[0], b = p[1], c = p[2], d = p[3];
    const float s = ((a[0] + a[1]) + (a[2] + a[3])) + ((b[0] + b[1]) + (b[2] + b[3])) + ((c[0] + c[1]) + (c[2] + c[3])) + ((d[0] + d[1]) + (d[2] + d[3])); return rsqrtf(s * (1.0f / 1024.0f) + 1e-6f); }
#define EPI_FENCE() asm volatile("" ::: "memory")
__device__ __forceinline__ void rstd_fill(PG8_LAS float* rc, const float* ssq, int pm, int row0, int fr) {
    if (__float_as_int(rc[0]) != pm) {
#pragma unroll
        for (int ai = 0; ai < 2; ++ai)
#pragma unroll
            for (int m = 0; m < 4; ++m) rc[8 + ai * 64 + m * 16 + fr] = rstd_row(ssq, row0 + ai * HALF + m * 16);
        rc[0] = __int_as_float(pm);
    }
}
__device__ __forceinline__ unsigned q8(float g) { return (unsigned)(g * 255.0f + 0.5f); }
__device__ __forceinline__ unsigned q8x4(float a, float b, float c, float d) { return q8(a) | (q8(b) << 8) | (q8(c) << 16) | (q8(d) << 24); }
__device__ __forceinline__ float dq8(unsigned w, int k) { return (float)((w >> (8 * k)) & 0xffu) * (1.0f / 255.0f); }

struct PairOrder {
    StaticOrder base;
    __host__ __device__ void init(int M, int G_, int c_) { base.init(M, 1024, G_, c_); }
    __host__ __device__ bool next(int i, Unit& u) const { Unit b; if (!base.next(i >> 1, b)) return false; u.pm = b.pm; u.pn = 2 * b.pn + (i & 1); return true; }
    __device__ __forceinline__ void a_ready(const Unit&) const {}
    __device__ __forceinline__ void done(const Unit&) const {}
};

struct EpiIn {
    static constexpr bool PERM = true, AFTER_DRAIN = false;
    const float* ssq; const float* ropec; const float* ropes; const float* bgate;
    bf16_t *Q, *K, *V, *U, *G; float* S; PG8_LAS float* rcache;
    __device__ __forceinline__ void operator()(const f32x4 (&acc)[2][2][4][2], const Unit& u, int wr, int wc, int fr, int fq) const {
        const int row0 = u.pm * BM + wr * 64 + fr; const int pn = u.pn;
        PG8_LAS float* rc = rcache + (wr * 4 + wc) * 136; rstd_fill(rc, ssq, u.pm, row0, fr);
        if (pn < 3) {
            const bool ropelane = ((wc & 1) == 0) && (fq < 2);
            const float QS = 0.125f * 1.4426950408889634f;
#pragma unroll
            for (int ai = 0; ai < 2; ++ai)
#pragma unroll
                for (int m = 0; m < 4; ++m) {
                    const int row = row0 + ai * HALF + m * 16; const float rs = rc[8 + ai * 64 + m * 16 + fr];
                    const f32x4 cs = *(const f32x4*)(ropec + (size_t)row * 8 + 4 * (fq & 1)), sn = *(const f32x4*)(ropes + (size_t)row * 8 + 4 * (fq & 1));
#pragma unroll
                    for (int bj = 0; bj < 2; ++bj) {
                        f32x4 v0 = acc[ai][bj][m][0] * rs, v1 = acc[ai][bj][m][1] * rs;
                        bf16_t* dst; bool rope = ropelane; float sc = 1.f;
                        if (pn < 2) { dst = Q + (size_t)row * 512 + pn * 256 + bj * HALF + wc * 32 + 8 * fq; sc = QS; }
                        else if (bj == 0) { dst = K + (size_t)row * 128 + wc * 32 + 8 * fq; }
                        else { dst = V + (size_t)row * 128 + wc * 32 + 8 * fq; rope = false; }
                        if (rope) { const f32x4 o0 = v0 * cs - v1 * sn, o1 = v1 * cs + v0 * sn; v0 = o0; v1 = o1; }
                        v0 = v0 * sc; v1 = v1 * sc;
                        u32x4 w; w.x = cvt_pk_bf16(v0[0], v0[1]); w.y = cvt_pk_bf16(v0[2], v0[3]); w.z = cvt_pk_bf16(v1[0], v1[1]); w.w = cvt_pk_bf16(v1[2], v1[3]);
                        *(u32x4*)dst = w;
                    }
                    if (m == 3) EPI_FENCE();
                }
        } else if (pn == 3) {
#pragma unroll
            for (int ai = 0; ai < 2; ++ai)
#pragma unroll
                for (int m = 0; m < 4; ++m) {
                    const int row = row0 + ai * HALF + m * 16; const float rs = rc[8 + ai * 64 + m * 16 + fr];
#pragma unroll
                    for (int bj = 0; bj < 2; ++bj) { const f32x4 v0 = acc[ai][bj][m][0] * rs, v1 = acc[ai][bj][m][1] * rs;
                        u32x4 w; w.x = cvt_pk_bf16(v0[0], v0[1]); w.y = cvt_pk_bf16(v0[2], v0[3]); w.z = cvt_pk_bf16(v1[0], v1[1]); w.w = cvt_pk_bf16(v1[2], v1[3]);
                        *(u32x4*)((bf16_t*)S + (size_t)row * 256 + bj * HALF + wc * 32 + 8 * fq) = w; }
                    if (m == 3) EPI_FENCE();
                }
        } else if (pn < 6) {
#pragma unroll
            for (int ai = 0; ai < 2; ++ai)
#pragma unroll
                for (int m = 0; m < 4; ++m) {
                    const int row = row0 + ai * HALF + m * 16; const float rs = rc[8 + ai * 64 + m * 16 + fr];
#pragma unroll
                    for (int bj = 0; bj < 2; ++bj) {
                        const f32x4 a = acc[ai][bj][m][0] * rs, g = acc[ai][bj][m][1] * rs;
                        u32x2 w; w.x = cvt_pk_bf16(a[0] * sigm(g[0]), a[1] * sigm(g[1])); w.y = cvt_pk_bf16(a[2] * sigm(g[2]), a[3] * sigm(g[3]));
                        *(u32x2*)(U + (size_t)row * 256 + (pn - 4) * 128 + bj * 64 + wc * 16 + fq * 4) = w;
                    }
                    if (m == 3) EPI_FENCE();
                }
        } else {
            const int colb = (pn - 6) * 256 + wc * 32 + 8 * fq;
            f32x4 bv[2][2];
#pragma unroll
            for (int bj = 0; bj < 2; ++bj)
#pragma unroll
                for (int n = 0; n < 2; ++n) bv[bj][n] = *(const f32x4*)(bgate + colb + bj * HALF + 4 * n);
#pragma unroll
            for (int ai = 0; ai < 2; ++ai)
#pragma unroll
                for (int m = 0; m < 4; ++m) {
                    const int row = row0 + ai * HALF + m * 16; const float rs = rc[8 + ai * 64 + m * 16 + fr];
#pragma unroll
                    for (int bj = 0; bj < 2; ++bj) {
                        const f32x4 v0 = acc[ai][bj][m][0] * rs + bv[bj][0], v1 = acc[ai][bj][m][1] * rs + bv[bj][1];
#if defined(DBG_GATE_LIN)
                        u32x2 w; w.x = 0u; w.y = 0u;
#else
                        u32x2 w; w.x = q8x4(sigm(v0[0]), sigm(v0[1]), sigm(v0[2]), sigm(v0[3])); w.y = q8x4(sigm(v1[0]), sigm(v1[1]), sigm(v1[2]), sigm(v1[3]));
#endif
                        *(u32x2*)((unsigned char*)G + (size_t)row * 3072 + colb + bj * HALF) = w;
                    }
                    if (m == 3) EPI_FENCE();
                }
        }
    }
};

template <int MODE> struct EpiMerge {
    static constexpr bool PERM = true, AFTER_DRAIN = false;
    const bf16_t* G; bf16_t* MG;
    __device__ __forceinline__ void operator()(const f32x4 (&acc)[2][2][4][2], const Unit& u, int wr, int wc, int fr, int fq) const {
        const int row0 = u.pm * BM + wr * 64 + fr; const int col0 = u.pn * BM + wc * 32 + 8 * fq;
        u32x2 gwv[2][4][2];
#pragma unroll
        for (int ai = 0; ai < 2; ++ai)
#pragma unroll
            for (int m = 0; m < 4; ++m)
#pragma unroll
                for (int bj = 0; bj < 2; ++bj)
                    gwv[ai][m][bj] = *(const u32x2*)((const unsigned char*)G + (size_t)(row0 + ai * HALF + m * 16) * 3072 + (MODE == 0 ? 0 : 2048) + col0 + bj * HALF);
#pragma unroll
        for (int ai = 0; ai < 2; ++ai) {
            u32x4 pwv[4][2];
            if (MODE == 1) {
#pragma unroll
                for (int m = 0; m < 4; ++m)
#pragma unroll
                    for (int bj = 0; bj < 2; ++bj) pwv[m][bj] = *(const u32x4*)(MG + (size_t)(row0 + ai * HALF + m * 16) * 1024 + col0 + bj * HALF);
            }
            EPI_FENCE();
#pragma unroll
            for (int m = 0; m < 4; ++m) {
                const int row = row0 + ai * HALF + m * 16;
#pragma unroll
                for (int bj = 0; bj < 2; ++bj) {
                    const u32x2 gw = gwv[ai][m][bj];
                    bf16_t* mp = MG + (size_t)row * 1024 + col0 + bj * HALF;
                    const f32x4 a0 = acc[ai][bj][m][0], a1 = acc[ai][bj][m][1];
                    float o[8] = {dq8(gw.x, 0) * a0[0], dq8(gw.x, 1) * a0[1], dq8(gw.x, 2) * a0[2], dq8(gw.x, 3) * a0[3], dq8(gw.y, 0) * a1[0], dq8(gw.y, 1) * a1[1], dq8(gw.y, 2) * a1[2], dq8(gw.y, 3) * a1[3]};
                    if (MODE == 1) { const u32x4 pw = pwv[m][bj]; o[0] += bf_lo(pw.x); o[1] += bf_hi(pw.x); o[2] += bf_lo(pw.y); o[3] += bf_hi(pw.y); o[4] += bf_lo(pw.z); o[5] += bf_hi(pw.z); o[6] += bf_lo(pw.w); o[7] += bf_hi(pw.w); }
                    u32x4 w; w.x = cvt_pk_bf16(o[0], o[1]); w.y = cvt_pk_bf16(o[2], o[3]); w.z = cvt_pk_bf16(o[4], o[5]); w.w = cvt_pk_bf16(o[6], o[7]);
                    *(u32x4*)mp = w;
                }
            }
            EPI_FENCE();
        }
    }
};
struct EpiGlu {
    static constexpr bool PERM = true, AFTER_DRAIN = false;
    const bf16_t* G; bf16_t* MG; const float* bias;
    __device__ __forceinline__ void operator()(const f32x4 (&acc)[2][2][4][2], const Unit& u, int wr, int wc, int fr, int fq) const {
        const int row0 = u.pm * BM + wr * 64 + fr; const int dc0 = u.pn * 128 + wc * 16 + fq * 4;
        f32x4 ba[2], bb[2];
#pragma unroll
        for (int bj = 0; bj < 2; ++bj) { ba[bj] = *(const f32x4*)(bias + dc0 + bj * 64); bb[bj] = *(const f32x4*)(bias + 1024 + dc0 + bj * 64); }
        unsigned gwv[2][4][2]; u32x2 pwv[2][4][2];
#pragma unroll
        for (int ai = 0; ai < 2; ++ai)
#pragma unroll
            for (int m = 0; m < 4; ++m)
#pragma unroll
                for (int bj = 0; bj < 2; ++bj) { const int row = row0 + ai * HALF + m * 16;
                    gwv[ai][m][bj] = *(const unsigned*)((const unsigned char*)G + (size_t)row * 3072 + 1024 + dc0 + bj * 64);
                    pwv[ai][m][bj] = *(const u32x2*)(MG + (size_t)row * 1024 + dc0 + bj * 64); }
        EPI_FENCE();
#pragma unroll
        for (int ai = 0; ai < 2; ++ai)
#pragma unroll
            for (int m = 0; m < 4; ++m) {
                const int row = row0 + ai * HALF + m * 16;
#pragma unroll
                for (int bj = 0; bj < 2; ++bj) {
                    const unsigned gw = gwv[ai][m][bj]; const u32x2 pw = pwv[ai][m][bj];
                    bf16_t* mp = MG + (size_t)row * 1024 + dc0 + bj * 64;
                    const f32x4 a = acc[ai][bj][m][0] + ba[bj], b = acc[ai][bj][m][1] + bb[bj];
                    const float o0 = bf_lo(pw.x) + dq8(gw, 0) * a[0] * sigm(b[0]), o1 = bf_hi(pw.x) + dq8(gw, 1) * a[1] * sigm(b[1]);
                    const float o2 = bf_lo(pw.y) + dq8(gw, 2) * a[2] * sigm(b[2]), o3 = bf_hi(pw.y) + dq8(gw, 3) * a[3] * sigm(b[3]);
                    u32x2 w; w.x = cvt_pk_bf16(o0, o1); w.y = cvt_pk_bf16(o2, o3); *(u32x2*)mp = w;
                }
            }
    }
};
struct EpiFfn {
    static constexpr bool PERM = true, AFTER_DRAIN = false;
    const float* ssq; bf16_t* H; PG8_LAS float* rcache;
    __device__ __forceinline__ void operator()(const f32x4 (&acc)[2][2][4][2], const Unit& u, int wr, int wc, int fr, int fq) const {
        const int row0 = u.pm * BM + wr * 64 + fr; const int hc0 = u.pn * 128 + wc * 16 + fq * 4;
        PG8_LAS float* rc = rcache + (wr * 4 + wc) * 136; rstd_fill(rc, ssq, u.pm, row0, fr);
#pragma unroll
        for (int ai = 0; ai < 2; ++ai)
#pragma unroll
            for (int m = 0; m < 4; ++m) {
                const int row = row0 + ai * HALF + m * 16; const float rs = rc[8 + ai * 64 + m * 16 + fr];
#pragma unroll
                for (int bj = 0; bj < 2; ++bj) {
                    const f32x4 g = acc[ai][bj][m][0] * rs, up = acc[ai][bj][m][1] * rs;
                    u32x2 w; w.x = cvt_pk_bf16(g[0] * sigm(g[0]) * up[0], g[1] * sigm(g[1]) * up[1]); w.y = cvt_pk_bf16(g[2] * sigm(g[2]) * up[2], g[3] * sigm(g[3]) * up[3]);
                    *(u32x2*)(H + (size_t)row * 2816 + hc0 + bj * 64) = w;
                }
                if (m == 3) EPI_FENCE();
            }
    }
};
struct EpiStore {
    static constexpr bool PERM = true, AFTER_DRAIN = false;
    bf16_t* O;
    __device__ __forceinline__ void operator()(const f32x4 (&acc)[2][2][4][2], const Unit& u, int wr, int wc, int fr, int fq) const {
        const int row0 = u.pm * BM + wr * 64 + fr; const int col0 = u.pn * BM + wc * 32 + 8 * fq;
#pragma unroll
        for (int ai = 0; ai < 2; ++ai)
#pragma unroll
            for (int m = 0; m < 4; ++m) {
                const int row = row0 + ai * HALF + m * 16;
#pragma unroll
                for (int bj = 0; bj < 2; ++bj) { const f32x4 v0 = acc[ai][bj][m][0], v1 = acc[ai][bj][m][1];
                    u32x4 w; w.x = cvt_pk_bf16(v0[0], v0[1]); w.y = cvt_pk_bf16(v0[2], v0[3]); w.z = cvt_pk_bf16(v1[0], v1[1]); w.w = cvt_pk_bf16(v1[2], v1[3]);
                    *(u32x4*)(O + (size_t)row * 1024 + col0 + bj * HALF) = w; }
            }
    }
};
template <int MODE> struct EpiRes {
    static constexpr bool PERM = true, AFTER_DRAIN = false;
    const bf16_t* xin; bf16_t* xout; float* ssq_out; const float* ssq_in; const bf16_t* E;
    __device__ __forceinline__ void operator()(const f32x4 (&acc)[2][2][4][2], const Unit& u, int wr, int wc, int fr, int fq) const {
        const int row0 = u.pm * BM + wr * 64 + fr; const int col0 = u.pn * BM + wc * 32 + 8 * fq;
#pragma unroll
        for (int ai = 0; ai < 2; ++ai)
#pragma unroll
            for (int m = 0; m < 4; ++m) {
                const int row = row0 + ai * HALF + m * 16; const size_t off = (size_t)row * 1024 + col0;
                float rs = 0.f; if (MODE == 1) rs = rstd_row(ssq_in, row);
                float s = 0.f;
#pragma unroll
                for (int bj = 0; bj < 2; ++bj) {
                    const size_t o2 = off + bj * HALF;
                    const u32x4 xw = *(const u32x4*)(xin + o2); const f32x4 a0 = acc[ai][bj][m][0], a1 = acc[ai][bj][m][1];
                    float v[8] = {bf_lo(xw.x), bf_hi(xw.x), bf_lo(xw.y), bf_hi(xw.y), bf_lo(xw.z), bf_hi(xw.z), bf_lo(xw.w), bf_hi(xw.w)};
                    if (MODE == 0) { v[0] += a0[0]; v[1] += a0[1]; v[2] += a0[2]; v[3] += a0[3]; v[4] += a1[0]; v[5] += a1[1]; v[6] += a1[2]; v[7] += a1[3]; }
                    else { const u32x4 ew = *(const u32x4*)(E + o2);
                        v[0] += sigm(a0[0] * rs) * bf_lo(ew.x); v[1] += sigm(a0[1] * rs) * bf_hi(ew.x); v[2] += sigm(a0[2] * rs) * bf_lo(ew.y); v[3] += sigm(a0[3] * rs) * bf_hi(ew.y);
                        v[4] += sigm(a1[0] * rs) * bf_lo(ew.z); v[5] += sigm(a1[1] * rs) * bf_hi(ew.z); v[6] += sigm(a1[2] * rs) * bf_lo(ew.w); v[7] += sigm(a1[3] * rs) * bf_hi(ew.w); }
                    u32x4 w; w.x = cvt_pk_bf16(v[0], v[1]); w.y = cvt_pk_bf16(v[2], v[3]); w.z = cvt_pk_bf16(v[4], v[5]); w.w = cvt_pk_bf16(v[6], v[7]);
                    *(u32x4*)(xout + o2) = w;
                    s += ((v[0] * v[0] + v[1] * v[1]) + (v[2] * v[2] + v[3] * v[3])) + ((v[4] * v[4] + v[5] * v[5]) + (v[6] * v[6] + v[7] * v[7]));
                }
                s += __shfl_xor(s, 16); s += __shfl_xor(s, 32);
                if (fq == 0) ssq_out[(size_t)row * 16 + u.pn * 4 + wc] = s;
                if (m == 3) EPI_FENCE();
            }
    }
};

struct EpiNull {
    static constexpr bool PERM = true, AFTER_DRAIN = false;
    float* sink;
    __device__ __forceinline__ void operator()(const f32x4 (&acc)[2][2][4][2], const Unit& u, int wr, int wc, int fr, int fq) const {
        float s = 0.f;
#pragma unroll
        for (int ai = 0; ai < 2; ++ai)
#pragma unroll
            for (int bj = 0; bj < 2; ++bj)
#pragma unroll
                for (int m = 0; m < 4; ++m)
#pragma unroll
                    for (int n = 0; n < 2; ++n) s += (acc[ai][bj][m][n][0] + acc[ai][bj][m][n][1]) + (acc[ai][bj][m][n][2] + acc[ai][bj][m][n][3]);
        if (s == 1.2345e-30f) sink[0] = 1.f;
    }
};
template <class Epi, class Sched, bool ALIGN_EPI = false, bool SP2 = false>
__device__ __forceinline__ void gemm_phase(PG8_LAS unsigned char* lds, const Gemm g, const Sched& S, const Epi& E) {
    int tid_ = threadIdx.x; asm volatile("" : "+v"(tid_));
    const int tid = tid_, wid = __builtin_amdgcn_readfirstlane(tid >> 6), lane = tid & 63, wr = wid >> 2, wc = wid & 3, fr = lane & 15, fq = lane >> 4;
    int K_ = g.K; asm volatile("" : "+s"(K_));
    const int K = K_, nt = K / BK;
    unsigned voffA[2], voffB[2];
#pragma unroll
    for (int i = 0; i < 2; ++i) { int R, C; stage_rc(tid * 16 + i * 8192, R, C); const int Rb = Epi::PERM ? ((R & ~31) + perm32(R & 31)) : R;
        voffA[i] = (unsigned)(R * K + C) * 2u; voffB[i] = (unsigned)(Rb * K + C) * 2u; }
    const size_t kstep = (size_t)(BK * 2);
    const size_t hstep = (size_t)HALF * K * 2;
    const size_t tstep = 2 * hstep;
    const unsigned ldsw = (unsigned)wid * 1024u;
    const int aoff = lds_byte(wr * 64 + fr, fq * 8), boff = lds_byte(wc * 32 + fr, fq * 8);
#define PG8_SA(b, h) (((b) * 2 + (h)) * HTB)
#define PG8_SB(b, h) ((4 + (b) * 2 + (h)) * HTB)
#define PG8_STAGE(bufoff, gbase, voff) do { _Pragma("unroll") for (int _i = 0; _i < 2; ++_i) \
        __builtin_amdgcn_global_load_lds((const unsigned*)((const char*)(gbase) + (voff)[_i]), (PG8_LAS unsigned*)(lds + (bufoff) + ldsw + _i * 8192), 16, 0, 0); } while (0)
#define PG8_LDA(dst, b, h) do { _Pragma("unroll") for (int m = 0; m < 4; ++m) _Pragma("unroll") for (int k = 0; k < 2; ++k) dst[m][k] = *(const PG8_LAS bf16x8*)(lds + PG8_SA(b, h) + aoff + m * 2048 + k * 1024); } while (0)
#define PG8_LDB(dst, b, h) do { _Pragma("unroll") for (int n = 0; n < 2; ++n) _Pragma("unroll") for (int k = 0; k < 2; ++k) dst[n][k] = *(const PG8_LAS bf16x8*)(lds + PG8_SB(b, h) + boff + n * 2048 + k * 1024); } while (0)
#define PG8_MMA(ai, bj, At, Bt) do { __builtin_amdgcn_s_setprio(1); _Pragma("unroll") for (int m = 0; m < 4; ++m) _Pragma("unroll") for (int n = 0; n < 2; ++n) _Pragma("unroll") for (int k = 0; k < 2; ++k) \
        acc[ai][bj][m][n] = __builtin_amdgcn_mfma_f32_16x16x32_bf16(Bt[n][k], At[m][k], acc[ai][bj][m][n], 0, 0, 0); __builtin_amdgcn_s_setprio(0); } while (0)
#define PG8_WAIT_V(n) asm volatile("s_waitcnt vmcnt(" #n ")" ::: "memory")
#define PG8_WAIT_L(n) asm volatile("s_waitcnt lgkmcnt(" #n ")" ::: "memory")
#define PG8_BAR __builtin_amdgcn_s_barrier()
#define PG8_SCHED __builtin_amdgcn_sched_barrier(0)
    Unit cur, nxt; int ui = 0;
    if (!S.next(0, cur)) return;
    f32x4 acc[2][2][4][2];
#pragma unroll
    for (int a = 0; a < 2; ++a)
#pragma unroll
        for (int b = 0; b < 2; ++b)
#pragma unroll
            for (int m = 0; m < 4; ++m)
#pragma unroll
                for (int n = 0; n < 2; ++n) acc[a][b][m][n] = (f32x4){0.f, 0.f, 0.f, 0.f};
    bf16x8 At[4][2], B0[2][2], B1[2][2];
    const char* cA = (const char*)g.A + (size_t)cur.pm * tstep; const char* cB = (const char*)g.Bt + (size_t)cur.pn * tstep;
    S.a_ready(cur);
    if constexpr (SP2) {
        PG8_STAGE(PG8_SB(0, 0), cB, voffB); PG8_STAGE(PG8_SB(0, 1), cB + hstep, voffB); PG8_STAGE(PG8_SA(0, 0), cA, voffA); PG8_STAGE(PG8_SA(0, 1), cA + hstep, voffA);
        if (wr == 1) PG8_BAR;
        PG8_WAIT_V(2); PG8_BAR;
        PG8_STAGE(PG8_SB(1, 0), cB + kstep, voffB); PG8_STAGE(PG8_SA(1, 0), cA + kstep, voffA); PG8_STAGE(PG8_SB(1, 1), cB + hstep + kstep, voffB);
        PG8_WAIT_V(6); PG8_BAR;
    } else {
        PG8_STAGE(PG8_SB(0, 0), cB, voffB); PG8_STAGE(PG8_SA(0, 0), cA, voffA); PG8_STAGE(PG8_SB(0, 1), cB + hstep, voffB); PG8_STAGE(PG8_SA(0, 1), cA + hstep, voffA);
        if (wr == 1) PG8_BAR;
        PG8_WAIT_V(4); PG8_BAR;
        PG8_STAGE(PG8_SB(1, 0), cB + kstep, voffB); PG8_STAGE(PG8_SA(1, 0), cA + kstep, voffA); PG8_STAGE(PG8_SB(1, 1), cB + hstep + kstep, voffB);
        PG8_WAIT_V(6); PG8_BAR;
    }
    for (;;) {
        const bool has_next = S.next(ui + 1, nxt);
        const char* nA = has_next ? (const char*)g.A + (size_t)nxt.pm * tstep : cA; const char* nB = has_next ? (const char*)g.Bt + (size_t)nxt.pn * tstep : cB;
        for (int t = 0; t < nt; t += 2) {
            const bool last = (t == nt - 2);
            const char* a1 = cA + (size_t)(t + 1) * kstep;
            const char* a2 = last ? nA : cA + (size_t)(t + 2) * kstep; const char* b2 = last ? nB : cB + (size_t)(t + 2) * kstep;
            const char* a3 = a2 + kstep; const char* b3 = b2 + kstep;
            if (last && has_next) S.a_ready(nxt);
            if constexpr (SP2) {
            PG8_LDB(B0, 0, 0); PG8_LDB(B1, 0, 1); PG8_SCHED; PG8_LDA(At, 0, 0); PG8_STAGE(PG8_SA(1, 1), a1 + hstep, voffA);
            PG8_WAIT_V(8); PG8_WAIT_L(0); PG8_BAR; PG8_MMA(0, 0, At, B0); PG8_MMA(0, 1, At, B1); PG8_BAR; PG8_SCHED;
            PG8_LDA(At, 0, 1); PG8_STAGE(PG8_SB(0, 0), b2, voffB); PG8_STAGE(PG8_SB(0, 1), b2 + hstep, voffB); PG8_STAGE(PG8_SA(0, 0), a2, voffA);
            PG8_WAIT_V(8); PG8_WAIT_L(0); PG8_BAR; PG8_MMA(1, 0, At, B0); PG8_MMA(1, 1, At, B1); PG8_BAR; PG8_SCHED;
            PG8_LDB(B0, 1, 0); PG8_LDB(B1, 1, 1); PG8_SCHED; PG8_LDA(At, 1, 0); PG8_STAGE(PG8_SA(0, 1), a2 + hstep, voffA);
            PG8_WAIT_V(8); PG8_WAIT_L(0); PG8_BAR; PG8_MMA(0, 0, At, B0); PG8_MMA(0, 1, At, B1); PG8_BAR; PG8_SCHED;
            PG8_LDA(At, 1, 1); PG8_STAGE(PG8_SB(1, 0), b3, voffB); PG8_STAGE(PG8_SB(1, 1), b3 + hstep, voffB); PG8_STAGE(PG8_SA(1, 0), a3, voffA);
            PG8_WAIT_V(8); PG8_WAIT_L(0); PG8_BAR; PG8_MMA(1, 0, At, B0); PG8_MMA(1, 1, At, B1); PG8_BAR; PG8_SCHED;
            } else {
            PG8_LDB(B0, 0, 0); PG8_SCHED; PG8_LDA(At, 0, 0); PG8_STAGE(PG8_SA(1, 1), a1 + hstep, voffA);
            PG8_WAIT_L(8); PG8_BAR; PG8_WAIT_L(0); PG8_MMA(0, 0, At, B0); PG8_BAR; PG8_SCHED;
            PG8_LDB(B1, 0, 1); PG8_STAGE(PG8_SB(0, 0), b2, voffB);
            PG8_BAR; PG8_WAIT_L(0); PG8_MMA(0, 1, At, B1); PG8_BAR;
            PG8_LDA(At, 0, 1); PG8_STAGE(PG8_SA(0, 0), a2, voffA);
            PG8_BAR; PG8_WAIT_L(0); PG8_MMA(1, 0, At, B0); PG8_BAR; PG8_SCHED;
            PG8_STAGE(PG8_SB(0, 1), b2 + hstep, voffB);
            PG8_WAIT_V(6); PG8_BAR; PG8_MMA(1, 1, At, B1); PG8_BAR;
            PG8_LDB(B0, 1, 0); PG8_SCHED; PG8_LDA(At, 1, 0); PG8_STAGE(PG8_SA(0, 1), a2 + hstep, voffA);
            PG8_WAIT_L(8); PG8_BAR; PG8_WAIT_L(0); PG8_MMA(0, 0, At, B0); PG8_BAR; PG8_SCHED;
            PG8_LDB(B1, 1, 1); PG8_STAGE(PG8_SB(1, 0), b3, voffB);
            PG8_BAR; PG8_WAIT_L(0); PG8_MMA(0, 1, At, B1); PG8_BAR;
            PG8_LDA(At, 1, 1); PG8_STAGE(PG8_SA(1, 0), a3, voffA);
            PG8_BAR; PG8_WAIT_L(0); PG8_MMA(1, 0, At, B0); PG8_BAR; PG8_SCHED;
            PG8_STAGE(PG8_SB(1, 1), b3 + hstep, voffB);
            PG8_WAIT_V(6); PG8_BAR; PG8_MMA(1, 1, At, B1); PG8_BAR;
            }
        }
        if constexpr (ALIGN_EPI) { if (wr == 0) PG8_BAR; }
        if constexpr (!Epi::AFTER_DRAIN) { E(acc, cur, wr, wc, fr, fq); S.done(cur); }
        if (!has_next) break;
#pragma unroll
        for (int a = 0; a < 2; ++a)
#pragma unroll
            for (int b = 0; b < 2; ++b)
#pragma unroll
                for (int m = 0; m < 4; ++m)
#pragma unroll
                    for (int n = 0; n < 2; ++n) acc[a][b][m][n] = (f32x4){0.f, 0.f, 0.f, 0.f};
        cur = nxt; cA = nA; cB = nB; ++ui;
        if constexpr (ALIGN_EPI) { if (wr == 1) PG8_BAR; }
    }
    PG8_WAIT_V(0);
    if constexpr (!ALIGN_EPI) { if (wr == 0) PG8_BAR; }
    PG8_BAR;
    if constexpr (Epi::AFTER_DRAIN) { E.fused(acc, cur, wr, wc, fr, fq, lds, wid, lane); S.done(cur); }
#undef PG8_SA
#undef PG8_SB
#undef PG8_STAGE
#undef PG8_LDA
#undef PG8_LDB
#undef PG8_MMA
#undef PG8_WAIT_V
#undef PG8_WAIT_L
#undef PG8_BAR
#undef PG8_SCHED
}
}

#define LAS __attribute__((address_space(3)))
typedef unsigned short bf16;
typedef unsigned u32x4 __attribute__((ext_vector_type(4)));
typedef unsigned u32x2 __attribute__((ext_vector_type(2)));
typedef float f32x4 __attribute__((ext_vector_type(4)));
typedef float f32x16 __attribute__((ext_vector_type(16)));
typedef short bf16x8 __attribute__((ext_vector_type(8)));
constexpr int M = 65536, D = 1024, SEQ = 4096, NIN = 4608, FF = 2816, DEPTH = 4;
constexpr size_t MiB = 1u << 20;
constexpr size_t WS_SSQ = 1 * MiB, WS_ROPE = 13 * MiB, WS_CARRY = 17 * MiB, WS_W = 26 * MiB, WS_XB = 156 * MiB, WS_ACT = 284 * MiB, WS_END = 988 * MiB;
constexpr size_t WO_IN = 0, WO_AO = WO_IN + (size_t)4608 * 1024, WO_GLU = WO_AO + (size_t)1024 * 512, WO_CO = WO_GLU + (size_t)2048 * 256, WO_MIX = WO_CO + (size_t)1024 * 256,
                 WO_FI = WO_MIX + (size_t)1024 * 1024, WO_FO = WO_FI + (size_t)5632 * 1024, WO_PI = WO_FO + (size_t)1024 * 2816, WO_PG = WO_PI + (size_t)1024 * 256, W_LAYER = WO_PG + (size_t)1024 * 1024;
static_assert(W_LAYER * 2 * DEPTH <= 130 * MiB, "weights fit");
constexpr size_t A_Q = 0, A_K = 64 * MiB, A_V = 80 * MiB, A_S = 96 * MiB, A_U = 160 * MiB, A_G = 192 * MiB, A_AO = 576 * MiB, A_YS = 640 * MiB, A_YC = 672 * MiB;
constexpr size_t A_MG = 0, A_HID = 0, A_E = 384 * MiB, A_PB = 576 * MiB;
static_assert((size_t)M * FF * 2 <= 384 * MiB, "hidden fits under E");
constexpr int LDS_BYTES = 147456, RING_BYTES = 131072;

#ifndef DBG_LAYERS
#define DBG_LAYERS DEPTH
#endif
#ifndef DBG_MASK
#define DBG_MASK 0xffffffffu
#endif
#ifndef DBG_USE_XB
#define DBG_USE_XB 0
#endif
#ifndef DBG_REP
#define DBG_REP 0u
#endif
#define REPS(bit) for (int rep_ = 0; rep_ < ((DBG_REP & (bit)) ? 2 : 1); ++rep_)
#ifndef DBG_MASK1
#define DBG_MASK1 DBG_MASK
#endif
struct Args { const void* in[31]; float* out; unsigned char* ws; float inv_freq[8]; unsigned mask; unsigned mask1; int ph_lo; int ph_hi; };
constexpr int NPH = 2 + 8 * DBG_LAYERS;

__device__ __forceinline__ float wave_sum(float v) {
#pragma unroll
    for (int o = 1; o < 64; o <<= 1) v += __shfl_xor(v, o);
    return v;
}
__device__ __forceinline__ unsigned pk2(float lo, float hi) { return pg8::cvt_pk_bf16(lo, hi); }
__device__ __forceinline__ float bflo(unsigned w) { return __uint_as_float(w << 16); }
__device__ __forceinline__ float bfhi(unsigned w) { return __uint_as_float(w & 0xffff0000u); }
__device__ __forceinline__ float sigm_(float x) { return __builtin_amdgcn_rcpf(1.0f + __expf(-x)); }
__device__ __forceinline__ int crow(int r, int hi) { return (r & 3) + 8 * (r >> 2) + 4 * hi; }

__device__ __forceinline__ int colmap(int mode, int np) {
    if (mode == 1) {
        if (np < 640) { const int hd = np & 63, base = np & ~63; int s = hd; if (hd < 16) { const int i = hd & 3, blk = hd >> 2; s = ((blk & 1) ? 8 : 0) + ((blk >> 1) ? 4 : 0) + i; } return base + s; }
        if (np < 1024) return np;
        if (np < 1536) { const int q = np - 1024, i = q >> 3, j = q & 7; return (j < 4) ? 1024 + 4 * i + j : 1280 + 4 * i + (j - 4); }
        return np;
    }
    if (mode == 2) { const int i = np >> 3, j = np & 7; return (j < 4) ? 4 * i + j : 2816 + 4 * i + (j - 4); }
    if (mode == 3) { const int i = np >> 3, j = np & 7; return (j < 4) ? 4 * i + j : 1024 + 4 * i + (j - 4); }
    return np;
}
__device__ __forceinline__ void cvt_item(const float* W, int K, int N, int mode, const float* gain, bf16* WT, LAS float* scr, int item, int lane) {
    const int nblk = N / 32, kb = item / nblk, nb = item % nblk, k0 = 64 * kb, n0 = 32 * nb;
    const int sc = colmap(mode, n0 + (lane & 31));
    float wv[32];
#pragma unroll
    for (int i = 0; i < 32; ++i) { const int kk = 2 * i + (lane >> 5); wv[i] = W[(size_t)(k0 + kk) * N + sc]; }
    if (gain) {
#pragma unroll
        for (int i = 0; i < 32; ++i) wv[i] *= gain[k0 + 2 * i + (lane >> 5)];
    }
#pragma unroll
    for (int i = 0; i < 32; ++i) { const int kk = 2 * i + (lane >> 5); scr[kk * 33 + (lane & 31)] = wv[i]; }
    asm volatile("s_waitcnt lgkmcnt(0)" ::: "memory");
    const int c = lane & 7;
#pragma unroll
    for (int j = 0; j < 4; ++j) { const int n = (lane >> 3) + 8 * j; const LAS float* s = scr + (8 * c) * 33 + n;
        u32x4 o; o.x = pk2(s[0 * 33], s[1 * 33]); o.y = pk2(s[2 * 33], s[3 * 33]); o.z = pk2(s[4 * 33], s[5 * 33]); o.w = pk2(s[6 * 33], s[7 * 33]);
        *(u32x4*)(WT + (size_t)(n0 + n) * K + k0 + 8 * c) = o; }
    asm volatile("s_waitcnt lgkmcnt(0)" ::: "memory");
}

__device__ __forceinline__ void attn_phase(LAS unsigned char* lds, const bf16* Q, const bf16* K, const bf16* V, bf16* AO, const float* sinks, int vcu, int G, int tid, int wid, int lane) {
    LAS unsigned char* Ks = lds;
    LAS unsigned short* Vt = (LAS unsigned short*)(lds + 36864);
    const int r32 = lane & 31, hi = lane >> 5;
    for (int unit = vcu; unit < 1024; unit += G) {
        const int b = unit >> 6, blk = (unit >> 1) & 31, kvh = unit & 1;
        const long band0 = (long)b * SEQ + blk * 128 - 128;
#pragma unroll
        for (int i = 0; i < 4; ++i) {
            const int c = tid + 512 * i, row = c >> 3, part = c & 7;
            u32x4 kv = (u32x4){0u, 0u, 0u, 0u}, vv = (u32x4){0u, 0u, 0u, 0u};
            if (blk > 0 || row >= 128) { kv = *(const u32x4*)(K + (band0 + row) * 128 + kvh * 64 + part * 8); vv = *(const u32x4*)(V + (band0 + row) * 128 + kvh * 64 + part * 8); }
            *(LAS u32x4*)(Ks + row * 144 + part * 16) = kv;
            LAS unsigned short* vp = Vt + (part * 8) * 264 + row;
            vp[0 * 264] = (unsigned short)(vv.x & 0xffffu); vp[1 * 264] = (unsigned short)(vv.x >> 16);
            vp[2 * 264] = (unsigned short)(vv.y & 0xffffu); vp[3 * 264] = (unsigned short)(vv.y >> 16);
            vp[4 * 264] = (unsigned short)(vv.z & 0xffffu); vp[5 * 264] = (unsigned short)(vv.z >> 16);
            vp[6 * 264] = (unsigned short)(vv.w & 0xffffu); vp[7 * 264] = (unsigned short)(vv.w >> 16);
        }
        __syncthreads();
        for (int it = 0; it < 2; ++it) {
            const int task = wid * 2 + it, g = task >> 2, j = task & 3, head = kvh * 4 + g;
            const long qrow = (long)b * SEQ + blk * 128 + 32 * j;
            bf16x8 qf[4];
#pragma unroll
            for (int d0 = 0; d0 < 4; ++d0) qf[d0] = *(const bf16x8*)(Q + (qrow + r32) * 512 + head * 64 + d0 * 16 + hi * 8);
            f32x16 p[5];
#pragma unroll
            for (int tt = 0; tt < 5; ++tt) {
#pragma unroll
                for (int r = 0; r < 16; ++r) p[tt][r] = 0.f;
#pragma unroll
                for (int d0 = 0; d0 < 4; ++d0) { const bf16x8 kf = *(const LAS bf16x8*)(Ks + (32 * (j + tt) + r32) * 144 + d0 * 32 + hi * 16); p[tt] = __builtin_amdgcn_mfma_f32_32x32x16_bf16(kf, qf[d0], p[tt], 0, 0, 0); }
            }
            const float sink2 = sinks[head] * 1.4426950408889634f;
            float mx = sink2;
#pragma unroll
            for (int tt = 0; tt < 5; ++tt)
#pragma unroll
                for (int r = 0; r < 16; ++r) { const int dd = 32 * tt + crow(r, hi) - r32, kj = 32 * (j + tt) + crow(r, hi); const bool ok = (dd >= 1) && (dd <= 128) && (blk > 0 || kj >= 128);
                    p[tt][r] = ok ? p[tt][r] : -1e30f; mx = fmaxf(mx, p[tt][r]); }
            mx = fmaxf(mx, __shfl_xor(mx, 32));
            float sum = 0.f;
#pragma unroll
            for (int tt = 0; tt < 5; ++tt)
#pragma unroll
                for (int r = 0; r < 16; ++r) { p[tt][r] = __builtin_amdgcn_exp2f(p[tt][r] - mx); sum += p[tt][r]; }
            sum += __shfl_xor(sum, 32);
            const float inv = 1.0f / (sum + __builtin_amdgcn_exp2f(sink2 - mx));
            f32x16 o[2];
#pragma unroll
            for (int r = 0; r < 16; ++r) { o[0][r] = 0.f; o[1][r] = 0.f; }
#pragma unroll
            for (int tt = 0; tt < 5; ++tt)
#pragma unroll
                for (int h2 = 0; h2 < 2; ++h2) {
                    u32x4 pw; pw.x = pk2(p[tt][8 * h2 + 0] * inv, p[tt][8 * h2 + 1] * inv); pw.y = pk2(p[tt][8 * h2 + 2] * inv, p[tt][8 * h2 + 3] * inv);
                    pw.z = pk2(p[tt][8 * h2 + 4] * inv, p[tt][8 * h2 + 5] * inv); pw.w = pk2(p[tt][8 * h2 + 6] * inv, p[tt][8 * h2 + 7] * inv);
                    const bf16x8 pa = __builtin_bit_cast(bf16x8, pw);
                    const int kvb = 32 * (j + tt) + 16 * h2;
#pragma unroll
                    for (int dh = 0; dh < 2; ++dh) {
                        const LAS unsigned short* vb = Vt + (32 * dh + r32) * 264 + kvb + 4 * hi;
                        const u32x2 lo = *(const LAS u32x2*)vb, hi2 = *(const LAS u32x2*)(vb + 8);
                        const u32x4 vw = (u32x4){lo.x, lo.y, hi2.x, hi2.y};
                        o[dh] = __builtin_amdgcn_mfma_f32_32x32x16_bf16(pa, __builtin_bit_cast(bf16x8, vw), o[dh], 0, 0, 0);
                    }
                }
#pragma unroll
            for (int dh = 0; dh < 2; ++dh)
#pragma unroll
                for (int r = 0; r < 16; r += 2) {
                    const unsigned w = pk2(o[dh][r], o[dh][r + 1]);
                    AO[(qrow + crow(r, hi)) * 512 + head * 64 + 32 * dh + r32] = (bf16)(w & 0xffffu);
                    AO[(qrow + crow(r + 1, hi)) * 512 + head * 64 + 32 * dh + r32] = (bf16)(w >> 16);
                }
        }
        __syncthreads();
    }
}

__device__ __forceinline__ void conv_phase(LAS unsigned char* lds, const bf16* U, bf16* YC, const float* dww, const float* dwb, const float* lng, const float* lnb, int vcu, int G, int tid, int wid, int lane) {
    LAS unsigned* Us = (LAS unsigned*)lds;
    LAS float* Cs = (LAS float*)(lds + 49152);
    const int c2 = tid & 127, tg = tid >> 7;
    float w0[31], w1[31];
#pragma unroll
    for (int j = 0; j < 31; ++j) { w0[j] = dww[j * 256 + 2 * c2]; w1[j] = dww[j * 256 + 2 * c2 + 1]; }
    const float b0 = dwb[2 * c2], b1 = dwb[2 * c2 + 1];
    const f32x4 gg = *(const f32x4*)(lng + 4 * lane), gb = *(const f32x4*)(lnb + 4 * lane);
    for (int tile = vcu; tile < 1024; tile += G) {
        const long t0 = (long)tile * 64; const int s0 = (tile & 63) * 64;
        for (int c = tid; c < 94 * 32; c += 512) { const int row = c >> 5, part = c & 31; u32x4 v = (u32x4){0u, 0u, 0u, 0u};
            if (s0 + row - 30 >= 0) v = *(const u32x4*)(U + (t0 + row - 30) * 256 + part * 8);
            *(LAS u32x4*)(lds + row * 512 + part * 16) = v; }
        __syncthreads();
        float a0[16], a1[16];
#pragma unroll
        for (int i = 0; i < 16; ++i) { a0[i] = b0; a1[i] = b1; }
#pragma unroll
        for (int r = 0; r < 46; ++r) { const unsigned uw = Us[(16 * tg + r) * 128 + c2]; const float u0 = bflo(uw), u1 = bfhi(uw);
#pragma unroll
            for (int i = 0; i < 16; ++i) { const int j = r - i; if (j >= 0 && j <= 30) { a0[i] += w0[j] * u0; a1[i] += w1[j] * u1; } } }
#pragma unroll
        for (int i = 0; i < 16; ++i) { LAS float* cp = Cs + (16 * tg + i) * 260 + 2 * c2; cp[0] = a0[i]; cp[1] = a1[i]; }
        __syncthreads();
#pragma unroll
        for (int k = 0; k < 8; ++k) { const int tok = 8 * wid + k; f32x4 v = *(const LAS f32x4*)(Cs + tok * 260 + 4 * lane);
            const float mean = wave_sum((v[0] + v[1]) + (v[2] + v[3])) * (1.0f / 256.0f); v = v - mean;
            const float var = wave_sum((v[0] * v[0] + v[1] * v[1]) + (v[2] * v[2] + v[3] * v[3])) * (1.0f / 256.0f); const float rstd = rsqrtf(var + 1e-6f);
            v = v * rstd * gg + gb;
            u32x2 w; w.x = pk2(v[0] * sigm_(v[0]), v[1] * sigm_(v[1])); w.y = pk2(v[2] * sigm_(v[2]), v[3] * sigm_(v[3]));
            *(u32x2*)(YC + (t0 + tok) * 256 + 4 * lane) = w; }
        __syncthreads();
    }
}

struct SsmCoef { float ar, ai; float br[16], bi[16]; };
__device__ __forceinline__ void ssm_coef(SsmCoef& c, const float* lam_re, const float* lam_im, const float* log_dt, const float* b_re, const float* b_im, int g, int n) {
    const float lr = fminf(lam_re[g * 64 + n], -1e-4f), li = lam_im[g * 64 + n], dt = expf(log_dt[g]);
    const float mag = expf(lr * dt); float sn, cs; sincosf(li * dt, &sn, &cs);
    c.ar = mag * cs; c.ai = mag * sn;
    const float den = lr * lr + li * li, xr = c.ar - 1.0f, xi = c.ai;
    const float fr = (xr * lr + xi * li) / den, fi = (xi * lr - xr * li) / den;
    const f32x4* pr = (const f32x4*)(b_re + (size_t)(g * 64 + n) * 16); const f32x4* pi = (const f32x4*)(b_im + (size_t)(g * 64 + n) * 16);
#pragma unroll
    for (int q = 0; q < 4; ++q) { const f32x4 r = pr[q], i = pi[q];
#pragma unroll
        for (int e = 0; e < 4; ++e) { c.br[4 * q + e] = fr * r[e] - fi * i[e]; c.bi[4 * q + e] = fr * i[e] + fi * r[e]; } }
}
__device__ __forceinline__ void ssm_stage_u(LAS float* us, const float* SIN, long row0, int g, int lane) {
    const bf16* S16 = (const bf16*)SIN;
#pragma unroll
    for (int i = 0; i < 2; ++i) { const int ch = lane + 64 * i, row = ch >> 1, hf = ch & 1; const u32x4 w = *(const u32x4*)(S16 + (row0 + row) * 256 + g * 16 + hf * 8);
        *(LAS f32x4*)(us + row * 16 + hf * 8) = (f32x4){bflo(w.x), bfhi(w.x), bflo(w.y), bfhi(w.y)}; *(LAS f32x4*)(us + row * 16 + hf * 8 + 4) = (f32x4){bflo(w.z), bfhi(w.z), bflo(w.w), bfhi(w.w)}; }
}
__device__ __forceinline__ void ssm_step(const SsmCoef& c, const LAS float* ut, float& sr, float& si) {
    const f32x4 u0 = *(const LAS f32x4*)(ut), u1 = *(const LAS f32x4*)(ut + 4), u2 = *(const LAS f32x4*)(ut + 8), u3 = *(const LAS f32x4*)(ut + 12);
    float br = 0.f, bi = 0.f;
#pragma unroll
    for (int e = 0; e < 4; ++e) { br += u0[e] * c.br[e]; bi += u0[e] * c.bi[e]; }
#pragma unroll
    for (int e = 0; e < 4; ++e) { br += u1[e] * c.br[4 + e]; bi += u1[e] * c.bi[4 + e]; }
#pragma unroll
    for (int e = 0; e < 4; ++e) { br += u2[e] * c.br[8 + e]; bi += u2[e] * c.bi[8 + e]; }
#pragma unroll
    for (int e = 0; e < 4; ++e) { br += u3[e] * c.br[12 + e]; bi += u3[e] * c.bi[12 + e]; }
    const float nr = c.ar * sr - c.ai * si + br, ni = c.ar * si + c.ai * sr + bi; sr = nr; si = ni;
}
constexpr size_t WS_COEF = 128 * 1024; constexpr int COEF_DW = 1280;
__device__ __forceinline__ void ssm_table(unsigned* tab, const float* lam_re, const float* lam_im, const float* log_dt, const float* b_re, const float* b_im, int g, int lane) {
    SsmCoef cf; ssm_coef(cf, lam_re, lam_im, log_dt, b_re, b_im, g, lane);
#pragma unroll
    for (int comp = 0; comp < 2; ++comp)
#pragma unroll
        for (int h2 = 0; h2 < 2; ++h2) { const int ct = (lane >> 5) * 2 + comp, cl = h2 * 32 + (lane & 31);
            u32x4 w;
            if (comp == 0) { w.x = pk2(cf.br[8 * h2 + 0], cf.br[8 * h2 + 1]); w.y = pk2(cf.br[8 * h2 + 2], cf.br[8 * h2 + 3]); w.z = pk2(cf.br[8 * h2 + 4], cf.br[8 * h2 + 5]); w.w = pk2(cf.br[8 * h2 + 6], cf.br[8 * h2 + 7]); }
            else           { w.x = pk2(cf.bi[8 * h2 + 0], cf.bi[8 * h2 + 1]); w.y = pk2(cf.bi[8 * h2 + 2], cf.bi[8 * h2 + 3]); w.z = pk2(cf.bi[8 * h2 + 4], cf.bi[8 * h2 + 5]); w.w = pk2(cf.bi[8 * h2 + 6], cf.bi[8 * h2 + 7]); }
            *(u32x4*)(tab + (ct * 64 + cl) * 4) = w; }
    float pr = cf.ar, pi = cf.ai;
#pragma unroll
    for (int q = 0; q < 6; ++q) { const float nr = pr * pr - pi * pi, ni = 2.0f * pr * pi; pr = nr; pi = ni; }
    float* tf = (float*)tab; tf[1024 + lane] = cf.ar; tf[1088 + lane] = cf.ai; tf[1152 + lane] = pr; tf[1216 + lane] = pi;
}
__device__ __forceinline__ void ssm_bu_tile(const LAS float* us32, LAS unsigned char* T, const bf16x8 (&bfr)[4], int r32, int hi) {
    const f32x4 ua = *(const LAS f32x4*)(us32 + r32 * 16 + 8 * hi), ub = *(const LAS f32x4*)(us32 + r32 * 16 + 8 * hi + 4);
    u32x4 aw; aw.x = pk2(ua[0], ua[1]); aw.y = pk2(ua[2], ua[3]); aw.z = pk2(ub[0], ub[1]); aw.w = pk2(ub[2], ub[3]);
    const bf16x8 af = __builtin_bit_cast(bf16x8, aw);
    f32x16 z;
#pragma unroll
    for (int r = 0; r < 16; ++r) z[r] = 0.f;
    const f32x16 d0 = __builtin_amdgcn_mfma_f32_32x32x16_bf16(af, bfr[0], z, 0, 0, 0), d1 = __builtin_amdgcn_mfma_f32_32x32x16_bf16(af, bfr[1], z, 0, 0, 0);
    const f32x16 d2 = __builtin_amdgcn_mfma_f32_32x32x16_bf16(af, bfr[2], z, 0, 0, 0), d3 = __builtin_amdgcn_mfma_f32_32x32x16_bf16(af, bfr[3], z, 0, 0, 0);
#pragma unroll
    for (int r = 0; r < 16; ++r) { LAS unsigned char* tp = T + crow(r, hi) * 272 + r32 * 4; *(LAS unsigned*)tp = pk2(d0[r], d1[r]); *(LAS unsigned*)(tp + 128) = pk2(d2[r], d3[r]); }
}
__device__ __forceinline__ void ssm_s1(LAS unsigned char* lds, const float* SIN, float* CARRY, const unsigned* coef, int vcu, int G, int wid, int lane) {
    LAS float* us = (LAS float*)(lds + wid * 12800);
    LAS unsigned char* T = lds + wid * 12800 + 4096;
    const int r32 = lane & 31, hi = lane >> 5;
    for (int task = vcu * 8 + wid; task < 16384; task += G * 8) {
        const int c = task >> 4, g = task & 15;
        const unsigned* tab = coef + (size_t)g * COEF_DW;
        bf16x8 bfr[4];
#pragma unroll
        for (int ct = 0; ct < 4; ++ct) bfr[ct] = __builtin_bit_cast(bf16x8, *(const u32x4*)(tab + (ct * 64 + lane) * 4));
        const float ar = ((const float*)tab)[1024 + lane], ai = ((const float*)tab)[1088 + lane];
        ssm_stage_u(us, SIN, (long)c * 64, g, lane);
        float sr = 0.f, si = 0.f;
#pragma unroll 1
        for (int half = 0; half < 2; ++half) {
            ssm_bu_tile(us + half * 512, T, bfr, r32, hi);
#pragma unroll 8
            for (int t = 0; t < 32; ++t) { const unsigned w = *(const LAS unsigned*)(T + t * 272 + lane * 4); const float nr = ar * sr - ai * si + bflo(w), ni = ar * si + ai * sr + bfhi(w); sr = nr; si = ni; }
        }
        *(float2*)(CARRY + ((size_t)(c * 16 + g) * 64 + lane) * 2) = make_float2(sr, si);
    }
}
__device__ __forceinline__ float gelu_tanh(float x) { const float z = 0.7978845608028654f * (x + 0.044715f * x * x * x); const float t = 1.0f - 2.0f * __builtin_amdgcn_rcpf(1.0f + __expf(2.0f * z)); return 0.5f * x * (1.0f + t); }
__device__ __forceinline__ void ssm_s3(LAS unsigned char* lds, const float* SIN, const float* CARRY, bf16* YS, const unsigned* coef,
                                       const float* c_re, const float* c_im, const float* dsk, int vcu, int G, int wid, int lane) {
    LAS float* us = (LAS float*)(lds + wid * 12800);
    LAS unsigned char* St = lds + wid * 12800 + 4096;
    const int r32 = lane & 31, hi = lane >> 5;
    for (int task = vcu * 8 + wid; task < 16384; task += G * 8) {
        const int c0 = task >> 4, g = task & 15, b = c0 >> 6, cs = ((c0 & 63) + 9 * (task >> 11)) & 63, c = b * 64 + cs;
        const unsigned* tab = coef + (size_t)g * COEF_DW;
        bf16x8 bfr[4];
#pragma unroll
        for (int ct = 0; ct < 4; ++ct) bfr[ct] = __builtin_bit_cast(bf16x8, *(const u32x4*)(tab + (ct * 64 + lane) * 4));
        const float ar = ((const float*)tab)[1024 + lane], ai = ((const float*)tab)[1088 + lane];
        bf16x8 ccf[8];
#pragma unroll
        for (int kk = 0; kk < 8; ++kk) { f32x4 cr = (f32x4){0.f, 0.f, 0.f, 0.f}, ci = cr;
            if (r32 < 16) { cr = *(const f32x4*)(c_re + (size_t)(g * 16 + r32) * 64 + 8 * kk + 4 * hi); ci = *(const f32x4*)(c_im + (size_t)(g * 16 + r32) * 64 + 8 * kk + 4 * hi); }
            u32x4 w; w.x = pk2(cr[0], -ci[0]); w.y = pk2(cr[1], -ci[1]); w.z = pk2(cr[2], -ci[2]); w.w = pk2(cr[3], -ci[3]); ccf[kk] = __builtin_bit_cast(bf16x8, w); }
        const float dk = (r32 < 16) ? dsk[g * 16 + r32] : 0.f;
        const float pr = ((const float*)tab)[1152 + lane], pi = ((const float*)tab)[1216 + lane];
        float sr = 0.f, si = 0.f;
        { const float* cb = CARRY + ((size_t)(b * 64 * 16 + g) * 64 + lane) * 2; int cp = 0;
          for (; cp + 8 <= cs; cp += 8) { float2 f[8];
#pragma unroll
              for (int k = 0; k < 8; ++k) f[k] = *(const float2*)(cb + (size_t)(cp + k) * 2048);
#pragma unroll
              for (int k = 0; k < 8; ++k) { const float nr = pr * sr - pi * si + f[k].x, ni = pr * si + pi * sr + f[k].y; sr = nr; si = ni; } }
          for (; cp < cs; ++cp) { const float2 f = *(const float2*)(cb + (size_t)cp * 2048);
              const float nr = pr * sr - pi * si + f.x, ni = pr * si + pi * sr + f.y; sr = nr; si = ni; } }
        ssm_stage_u(us, SIN, (long)c * 64, g, lane);
#pragma unroll 1
        for (int half = 0; half < 2; ++half) {
            ssm_bu_tile(us + half * 512, St, bfr, r32, hi);
#pragma unroll 8
            for (int t = 0; t < 32; ++t) { LAS unsigned* tp = (LAS unsigned*)(St + t * 272 + lane * 4); const unsigned w = *tp; const float nr = ar * sr - ai * si + bflo(w), ni = ar * si + ai * sr + bfhi(w); sr = nr; si = ni; *tp = pk2(sr, si); }
            f32x16 y;
#pragma unroll
            for (int r = 0; r < 16; ++r) y[r] = 0.f;
#pragma unroll
            for (int kk = 0; kk < 8; ++kk) { const bf16x8 af = *(const LAS bf16x8*)(St + r32 * 272 + kk * 32 + hi * 16); y = __builtin_amdgcn_mfma_f32_32x32x16_bf16(af, ccf[kk], y, 0, 0, 0); }
            if (r32 < 16) {
#pragma unroll
                for (int r = 0; r < 16; ++r) { const int t = half * 32 + crow(r, hi); const float v = y[r] + dk * us[t * 16 + r32];
                    YS[((long)c * 64 + t) * 256 + g * 16 + r32] = (bf16)(pk2(gelu_tanh(v), 0.f) & 0xffffu); }
            }
        }
    }
}

#define XB_TMO      128
#define XB_XCNT(j)  (256  + 64 * (j))
#define XB_XSUB(j)  (1280 + 64 * (j))
#define XB_XGEN(j)  (2304 + 64 * (j))
#define XB_TOP      3328
#define XB_TOPGEN   3392
#define XCD_BAR_WORDS 3456
#define XB_SPIN_CAP (1u << 23)

__device__ __forceinline__ unsigned xb_ld(unsigned* p)              { return __hip_atomic_load(p, __ATOMIC_RELAXED, __HIP_MEMORY_SCOPE_AGENT); }
__device__ __forceinline__ unsigned xb_add(unsigned* p, unsigned v) { return __hip_atomic_fetch_add(p, v, __ATOMIC_RELAXED, __HIP_MEMORY_SCOPE_AGENT); }
__device__ __forceinline__ unsigned xb_xcc_id() { return (unsigned)__builtin_amdgcn_s_getreg((3 << 11) | 20) & 0xFu; }
#define XB_SPIN(cond, bar) do { unsigned _sp = 0; while (cond) { __builtin_amdgcn_s_sleep(1); \
    if ((++_sp & 255u) == 0u) { if (xb_ld(&(bar)[XB_TMO])) break; if (_sp > XB_SPIN_CAP) { atomicAdd(&(bar)[XB_TMO], 1u); break; } } } } while (0)

struct XcdBarrier {
    unsigned* bar; unsigned x;
    volatile LAS unsigned* st;
};

__device__ __forceinline__ XcdBarrier xcd_barrier_post(unsigned* bar, volatile LAS unsigned* st) {
    XcdBarrier b; b.bar = bar; b.x = xb_xcc_id(); b.st = st;
    if (threadIdx.x == 0) (void)xb_add(&bar[XB_XCNT(b.x)], 1u);
    return b;
}
__device__ __forceinline__ void xcd_barrier_complete(unsigned* bar, unsigned x, unsigned& nloc, unsigned& nx) {
    const unsigned G = gridDim.x * gridDim.y * gridDim.z;
    unsigned sum, cnt, mine, sp = 0u;
    for (;;) {
        sum = 0u; cnt = 0u; mine = 0u;
#pragma unroll
        for (unsigned j = 0; j < 16; ++j) { const unsigned c = xb_ld(&bar[XB_XCNT(j)]); sum += c; cnt += (c > 0u) ? 1u : 0u; mine = (j == x) ? c : mine; }
        if (sum == G) break;
        __builtin_amdgcn_s_sleep(1);
        if ((++sp & 255u) == 0u) { if (xb_ld(&bar[XB_TMO])) break; if (sp > XB_SPIN_CAP) { atomicAdd(&bar[XB_TMO], 1u); break; } }
    }
    nloc = mine > 0u ? mine : 1u; nx = cnt > 0u ? cnt : 1u;
}

__device__ __forceinline__ void xcd_barrier(const XcdBarrier& b) {
    asm volatile("s_waitcnt vmcnt(0)" ::: "memory");
    __syncthreads();
    if (threadIdx.x == 0) {
        unsigned* bar = b.bar; const unsigned bx_ = xb_xcc_id();
        __builtin_amdgcn_s_waitcnt(0);
        unsigned nloc = b.st[0], nx = b.st[1];
        if (nloc == 0u) { xcd_barrier_complete(bar, bx_, nloc, nx); b.st[0] = nloc; b.st[1] = nx; }
        const unsigned old = xb_add(&bar[XB_XSUB(bx_)], 1u);
        const unsigned gen = old / nloc;
        if (old + 1u == (gen + 1u) * nloc) {
            __builtin_amdgcn_fence(__ATOMIC_RELEASE, "agent");
            asm volatile("s_waitcnt vmcnt(0)" ::: "memory");
            const unsigned og = xb_add(&bar[XB_TOP], 1u);
            const unsigned tg = og / nx;
            if (og + 1u == (tg + 1u) * nx) xb_add(&bar[XB_TOPGEN], 1u);
            else XB_SPIN(xb_ld(&bar[XB_TOPGEN]) == tg, bar);
            __builtin_amdgcn_fence(__ATOMIC_ACQUIRE, "agent");
            xb_add(&bar[XB_XGEN(bx_)], 1u);
            asm volatile("s_waitcnt vmcnt(0)" ::: "memory");
        } else {
            XB_SPIN(xb_ld(&bar[XB_XGEN(bx_)]) == gen, bar);
            __builtin_amdgcn_fence(__ATOMIC_ACQUIRE, "agent");
            asm volatile("s_waitcnt vmcnt(0)" ::: "memory");
        }
    }
    __syncthreads();
}

#define GRID_SYNC() xcd_barrier(xbar)
__device__ __forceinline__ const void* karg(int idx) { const __attribute__((address_space(1))) char* p; const void* kp = (const void*)__builtin_amdgcn_kernarg_segment_ptr(); asm volatile("s_load_dwordx2 %0, %1, %2\n\ts_waitcnt lgkmcnt(0)" : "=s"(p) : "s"(kp), "i"(idx * 8)); return (const void*)p; }
__global__ void __launch_bounds__(512, 2) mega_fwd(Args a) {
    extern __shared__ __attribute__((aligned(16))) unsigned char lds_raw[];
    LAS unsigned char* lds = (LAS unsigned char*)lds_raw;
    cg::grid_group grid = cg::this_grid();
    if (threadIdx.x < 64) ((volatile LAS unsigned*)(lds + RING_BYTES))[threadIdx.x] = 0u;
    __syncthreads();
    XcdBarrier xbar = xcd_barrier_post((unsigned*)a.ws, (volatile LAS unsigned*)(lds + RING_BYTES) + 8);
    if (a.ph_lo == 0 && a.ph_hi == NPH) grid.sync();
    const int tid = threadIdx.x, lane = tid & 63, wid = __builtin_amdgcn_readfirstlane(tid >> 6);
    const int G = gridDim.x, bx = blockIdx.x, vcu = (G % 8 == 0) ? (bx % 8) * (G / 8) + bx / 8 : bx;
    unsigned char* ws = a.ws;
    float* SSQA = (float*)(ws + WS_SSQ); float* SSQB = SSQA + (size_t)M * 16; float* SSQC = SSQB + (size_t)M * 16; float* ROPEC = (float*)(ws + WS_ROPE); float* ROPES = ROPEC + (size_t)M * 8; float* CARRY = (float*)(ws + WS_CARRY); unsigned* COEF = (unsigned*)(ws + WS_COEF);
    bf16* WB = (bf16*)(ws + WS_W); bf16* XB = (bf16*)(ws + WS_XB); unsigned char* ACT = ws + WS_ACT;
    bf16* Qb = (bf16*)(ACT + A_Q); bf16* Kb = (bf16*)(ACT + A_K); bf16* Vb = (bf16*)(ACT + A_V); float* Sb = (float*)(ACT + A_S); bf16* Ub = (bf16*)(ACT + A_U); bf16* Gb = (bf16*)(ACT + A_G);
    bf16* AOb = (bf16*)(ACT + A_AO); bf16* YSb = (bf16*)(ACT + A_YS); bf16* YCb = (bf16*)(ACT + A_YC); bf16* MGb = (bf16*)(ACT + A_MG); bf16* HIDb = (bf16*)(ACT + A_HID); bf16* Eb = (bf16*)(ACT + A_E); bf16* PBb = (bf16*)(ACT + A_PB); bf16* XBR = (bf16*)a.out;
    const float* x_in = (const float*)karg(0);
    const int gw = vcu * 8 + wid, NGW = G * 8;

    int ph = 0; unsigned pmask = 0u;
#define IN_RANGE() (ph >= a.ph_lo && ph < a.ph_hi)
#if defined(DBG_BAR2)
#define XBAR2() xcd_barrier(xbar)
#else
#define XBAR2() do {} while (0)
#endif
#define NEXT_PHASE(bm) do { if (ph >= a.ph_lo && ph + 1 < a.ph_hi) { xcd_barrier(xbar); XBAR2(); } ++ph; pmask = IN_RANGE() ? (bm) : 0u; } while (0)
    REPS(0x10000u) if (IN_RANGE()) {
        for (int i = bx * 512 + tid; i < M * 8; i += G * 512) { const int row = i >> 3, k = i & 7; const float ang = (float)((const int*)karg(2))[row] * a.inv_freq[k]; float sn, cs; sincosf(ang, &sn, &cs); ROPEC[i] = cs; ROPES[i] = sn; }
        for (int m0 = gw; m0 < M; m0 += 2 * NGW) {
            f32x4 xv[2][4];
#pragma unroll
            for (int q = 0; q < 2; ++q) { const int m = m0 + q * NGW; const f32x4* xr = (const f32x4*)(x_in + (size_t)(m < M ? m : m0) * D) + lane;
#pragma unroll
                for (int j = 0; j < 4; ++j) xv[q][j] = xr[64 * j]; }
#pragma unroll
            for (int q = 0; q < 2; ++q) { const int m = m0 + q * NGW; if (m < M) { u32x2* o = (u32x2*)(XBR + (size_t)m * D) + lane; float s = 0.f;
#pragma unroll
                for (int j = 0; j < 4; ++j) { const f32x4 v = xv[q][j]; s += (v[0] * v[0] + v[1] * v[1]) + (v[2] * v[2] + v[3] * v[3]); u32x2 w; w.x = pk2(v[0], v[1]); w.y = pk2(v[2], v[3]); o[64 * j] = w; }
                s = wave_sum(s); if (lane < 16) SSQC[(size_t)m * 16 + lane] = (lane == 0) ? s : 0.f; } } }
        if (gw < DEPTH * 16) { const int Lt = gw >> 4, gt = gw & 15; ssm_table(COEF + (size_t)gw * COEF_DW, (const float*)karg(8) + Lt * 1024, (const float*)karg(9) + Lt * 1024, (const float*)karg(10) + Lt * 16, (const float*)karg(11) + (size_t)Lt * 16384, (const float*)karg(12) + (size_t)Lt * 16384, gt, lane); }
        LAS float* scr = (LAS float*)(lds + wid * 16384);
        constexpr int I_IN = 16 * 144, I_AO = 8 * 32, I_GLU = 4 * 64, I_CO = 4 * 32, I_MIX = 16 * 32, I_FI = 16 * 176, I_FO = 44 * 32, I_PI = 4 * 32, I_PG = 16 * 32;
        constexpr int I_LAYER = I_IN + I_AO + I_GLU + I_CO + I_MIX + I_FI + I_FO + I_PI + I_PG;
        for (int it = gw; it < I_LAYER * DEPTH; it += NGW) {
            const int L = it / I_LAYER; int r = it % I_LAYER; bf16* wl = WB + (size_t)L * W_LAYER;
            if (r < I_IN) { cvt_item((const float*)karg(4) + (size_t)L * 1024 * 4608, 1024, 4608, 1, (const float*)karg(3) + L * 1024, wl + WO_IN, scr, r, lane); continue; } r -= I_IN;
            if (r < I_AO) { cvt_item((const float*)karg(7) + (size_t)L * 512 * 1024, 512, 1024, 0, nullptr, wl + WO_AO, scr, r, lane); continue; } r -= I_AO;
            if (r < I_GLU) { cvt_item((const float*)karg(16) + (size_t)L * 256 * 2048, 256, 2048, 3, nullptr, wl + WO_GLU, scr, r, lane); continue; } r -= I_GLU;
            if (r < I_CO) { cvt_item((const float*)karg(22) + (size_t)L * 256 * 1024, 256, 1024, 0, nullptr, wl + WO_CO, scr, r, lane); continue; } r -= I_CO;
            if (r < I_MIX) { cvt_item((const float*)karg(23) + (size_t)L * 1024 * 1024, 1024, 1024, 0, nullptr, wl + WO_MIX, scr, r, lane); continue; } r -= I_MIX;
            if (r < I_FI) { cvt_item((const float*)karg(25) + (size_t)L * 1024 * 5632, 1024, 5632, 2, (const float*)karg(24) + L * 1024, wl + WO_FI, scr, r, lane); continue; } r -= I_FI;
            if (r < I_FO) { cvt_item((const float*)karg(26) + (size_t)L * 2816 * 1024, 2816, 1024, 0, nullptr, wl + WO_FO, scr, r, lane); continue; } r -= I_FO;
            if (r < I_PI) { cvt_item((const float*)karg(27) + (size_t)L * 256 * 1024, 256, 1024, 0, nullptr, wl + WO_PI, scr, r, lane); continue; } r -= I_PI;
            cvt_item((const float*)karg(29) + (size_t)L * 1024 * 1024, 1024, 1024, 0, (const float*)karg(28) + L * 1024, wl + WO_PG, scr, r, lane);
        }
    }
    NEXT_PHASE(a.mask);

#ifndef STAG_SCALE
#define STAG_SCALE 0
#endif
#define STAGGER(n) do { if ((bx >> 3) & 1) { for (int s_ = 0; s_ < (n) * STAG_SCALE; ++s_) __builtin_amdgcn_s_sleep(127); } } while (0)
#define FRESH_IDS() int tid2 = threadIdx.x; asm volatile("" : "+v"(tid2)); const int lane2 = tid2 & 63, wid2 = __builtin_amdgcn_readfirstlane(tid2 >> 6)
#pragma unroll 1
    for (int L = 0; L < DBG_LAYERS; ++L) {
        const bf16* wl = WB + (size_t)L * W_LAYER;
        const bf16* xcur = XBR;
        bf16* xnext = (L == DBG_LAYERS - 1) ? MGb : XBR;
        const unsigned bmask = (L == 0) ? a.mask : a.mask1; pmask = IN_RANGE() ? bmask : 0u;
#ifndef SKIP_P1
        REPS(1u) if (pmask & 1u)
        {
            if (lane == 0) ((LAS float*)(lds + RING_BYTES + 1024))[wid * 136] = __int_as_float(-1);
            STAGGER(2); pg8::Gemm g{xcur, wl + WO_IN, M, NIN, D};   pg8::StaticOrder S; S.init(M, NIN, G, bx);
            pg8::EpiIn E{SSQC, ROPEC, ROPES, (const float*)karg(5) + L * 3072, Qb, Kb, Vb, Ub, Gb, Sb, (LAS float*)(lds + RING_BYTES + 1024)};
            pg8::gemm_phase<pg8::EpiIn, pg8::StaticOrder, true, true>(lds, g, S, E);
        }
#endif
        NEXT_PHASE(bmask);
#ifndef SKIP_ATTN
        REPS(2u) if (pmask & 2u) { FRESH_IDS();
        attn_phase(lds, Qb, Kb, Vb, AOb, (const float*)karg(6) + L * 8, vcu, G, tid2, wid2, lane2); }
#endif
#ifndef SKIP_CONV
        REPS(4u) if (pmask & 4u) { FRESH_IDS();
        conv_phase(lds, Ub, YCb, (const float*)karg(18) + L * 31 * 256, (const float*)karg(19) + L * 256, (const float*)karg(20) + L * 256, (const float*)karg(21) + L * 256, vcu, G, tid2, wid2, lane2); }
#endif
#ifndef SKIP_S1
        REPS(8u) if (pmask & 8u) { FRESH_IDS();
        ssm_s1(lds, Sb, CARRY, COEF + (size_t)L * 16 * COEF_DW, vcu, G, wid2, lane2); }
#endif
        NEXT_PHASE(bmask);
#ifndef SKIP_S3
        REPS(16u) if (pmask & 16u) { FRESH_IDS();
        ssm_s3(lds, Sb, CARRY, YSb, COEF + (size_t)L * 16 * COEF_DW,
               (const float*)karg(13) + (size_t)L * 16384, (const float*)karg(14) + (size_t)L * 16384, (const float*)karg(15) + L * 256, vcu, G, wid2, lane2); }
#endif
        NEXT_PHASE(bmask);
#ifndef SKIP_P3
        REPS(32u) {
            if (pmask & 32u) { STAGGER(3); pg8::Gemm g{AOb, wl + WO_AO, M, D, 512}; pg8::StaticOrder S; S.init(M, D, G, bx); pg8::EpiMerge<0> E{Gb, MGb};
              pg8::gemm_phase<pg8::EpiMerge<0>, pg8::StaticOrder, true, true>(lds, g, S, E); }
            asm volatile("s_waitcnt vmcnt(0)" ::: "memory"); __syncthreads();
            if (pmask & 64u) { pg8::Gemm g{YCb, wl + WO_CO, M, D, 256}; pg8::StaticOrder S; S.init(M, D, G, bx); pg8::EpiMerge<1> E{Gb, MGb};
              pg8::gemm_phase<pg8::EpiMerge<1>, pg8::StaticOrder, true, true>(lds, g, S, E); }
            asm volatile("s_waitcnt vmcnt(0)" ::: "memory"); __syncthreads();
            if (pmask & 128u) { pg8::Gemm g{YSb, wl + WO_GLU, M, 2048, 256}; pg8::PairOrder S; S.init(M, G, bx); pg8::EpiGlu E{Gb, MGb, (const float*)karg(17) + L * 2048};
              pg8::gemm_phase<pg8::EpiGlu, pg8::PairOrder, true, true>(lds, g, S, E); }
        }
#endif
        NEXT_PHASE(bmask);
#ifndef SKIP_P4
        REPS(256u) if (pmask & 256u)
        {
#if defined(DBG_DRY) && DBG_DRY == 1
            { pg8::Gemm g{MGb, wl + WO_MIX, M, D, D}; pg8::StaticOrder S; S.init(M, D, G, bx); pg8::EpiNull E{(float*)CARRY}; pg8::gemm_phase<pg8::EpiNull, pg8::StaticOrder, true, true>(lds, g, S, E); }
#endif
            STAGGER(3); pg8::Gemm g{MGb, wl + WO_MIX, M, D, D}; pg8::StaticOrder S; S.init(M, D, G, bx);
            pg8::EpiRes<0> E{xcur, XB, SSQA, nullptr, nullptr};
            pg8::gemm_phase<pg8::EpiRes<0>, pg8::StaticOrder, true, true>(lds, g, S, E);
        }
#endif
        NEXT_PHASE(bmask);
#ifndef SKIP_P5
        REPS(512u) if (pmask & 512u)
        {
            const f32x4* ps = (const f32x4*)((const float*)karg(1) + (size_t)L * M * 256);
            FRESH_IDS(); (void)lane2; (void)wid2;
            for (int i = bx * 512 + tid2; i < M * 256 / 8; i += G * 512) { const f32x4 v0 = ps[2 * (size_t)i], v1 = ps[2 * (size_t)i + 1];
                u32x4 w; w.x = pk2(v0[0], v0[1]); w.y = pk2(v0[2], v0[3]); w.z = pk2(v1[0], v1[1]); w.w = pk2(v1[2], v1[3]); ((u32x4*)PBb)[i] = w; }
            if (lane == 0) ((LAS float*)(lds + RING_BYTES + 1024))[wid * 136] = __int_as_float(-1);
            STAGGER(2); pg8::Gemm g{XB, wl + WO_FI, M, 2 * FF, D}; pg8::StaticOrder S; S.init(M, 2 * FF, G, bx);
            pg8::EpiFfn E{SSQA, HIDb, (LAS float*)(lds + RING_BYTES + 1024)};
            pg8::gemm_phase<pg8::EpiFfn, pg8::StaticOrder, true, true>(lds, g, S, E);
        }
#endif
        NEXT_PHASE(bmask);
#ifndef SKIP_P6
        {
#if defined(DBG_DRY)
            { pg8::Gemm g{HIDb, wl + WO_FO, M, D, FF}; pg8::StaticOrder S; S.init(M, D, G, bx); pg8::EpiNull E{(float*)CARRY}; pg8::gemm_phase<pg8::EpiNull, pg8::StaticOrder, true, true>(lds, g, S, E); }
#endif
            if (pmask & 1024u) { STAGGER(5); pg8::Gemm g{HIDb, wl + WO_FO, M, D, FF}; pg8::StaticOrder S; S.init(M, D, G, bx);
              pg8::EpiRes<0> E{XB, XB, SSQB, nullptr, nullptr};
              pg8::gemm_phase<pg8::EpiRes<0>, pg8::StaticOrder, true, true>(lds, g, S, E); }
            REPS(2048u) if (pmask & 2048u) { pg8::Gemm g{PBb, wl + WO_PI, M, D, 256}; pg8::StaticOrder S; S.init(M, D, G, bx); pg8::EpiStore E{Eb};
              pg8::gemm_phase<pg8::EpiStore, pg8::StaticOrder, true, true>(lds, g, S, E); }
        }
#endif
        NEXT_PHASE(bmask);
#ifndef SKIP_P7
        REPS(4096u) if (pmask & 4096u)
        {
#if defined(DBG_DRY) && DBG_DRY == 1
            { pg8::Gemm g{XB, wl + WO_PG, M, D, D}; pg8::StaticOrder S; S.init(M, D, G, bx); pg8::EpiNull E{(float*)CARRY}; pg8::gemm_phase<pg8::EpiNull, pg8::StaticOrder, true, true>(lds, g, S, E); }
#endif
            STAGGER(3); pg8::Gemm g{XB, wl + WO_PG, M, D, D}; pg8::StaticOrder S; S.init(M, D, G, bx);
            pg8::EpiRes<1> E{XB, xnext, SSQC, SSQB, Eb};
            pg8::gemm_phase<pg8::EpiRes<1>, pg8::StaticOrder, true, true>(lds, g, S, E);
        }
#endif
        NEXT_PHASE(bmask);
    }
#if defined(DBG_DUMP)
    if (IN_RANGE()) {
        FRESH_IDS(); (void)lane2; (void)wid2;
        const size_t n = (size_t)M * D;
        for (size_t i = (size_t)bx * 512 + tid2; i < n; i += (size_t)G * 512) {
            float v = 0.f;
#if DBG_DUMP == 1
            if (i < (size_t)M * 512) v = bflo((unsigned)Qb[i]); else if (i < (size_t)M * 640) v = bflo((unsigned)Kb[i - (size_t)M * 512]); else if (i < (size_t)M * 768) v = bflo((unsigned)Vb[i - (size_t)M * 640]); else v = Sb[i - (size_t)M * 768];
#elif DBG_DUMP == 2
            if (i < (size_t)M * 512) v = bflo((unsigned)AOb[i]); else if (i < (size_t)M * 768) v = bflo((unsigned)YCb[i - (size_t)M * 512]); else v = bflo((unsigned)YSb[i - (size_t)M * 768]);
#elif DBG_DUMP == 3
            v = bflo((unsigned)MGb[i]);
#elif DBG_DUMP == 6
            if (i < n / 2) v = bflo((unsigned)XBR[i]); else v = SSQC[(size_t)((i - n / 2) >> 9) * 16];
#elif DBG_DUMP == 7
            if (i < 3 * W_LAYER) v = bflo((unsigned)WB[W_LAYER + i]); else v = 0.f;
#elif DBG_DUMP == 8
            if (i < (size_t)M * 256) v = Sb[i]; else v = 0.f;
#elif DBG_DUMP == 9
            if (i < (size_t)M * 8) v = ROPEC[i]; else if (i < (size_t)M * 16) v = ROPES[i - (size_t)M * 8]; else if (i < (size_t)M * 32) v = SSQC[i - (size_t)M * 16]; else if (i < (size_t)M * 544) v = bflo((unsigned)XBR[(size_t)M * 512 + (i - (size_t)M * 32)]); else v = 0.f;
#elif DBG_DUMP == 10
            if (i < (size_t)M * 16) v = SSQC[i]; else v = 0.f;
#elif DBG_DUMP == 11
            if (i < (size_t)M * 512) v = bflo((unsigned)XBR[(size_t)M * 512 + i]); else v = 0.f;
#elif DBG_DUMP == 5
            if (i < (size_t)M * 256) v = bflo((unsigned)Ub[i]); else if (i < (size_t)M * 768) v = bflo((unsigned)Gb[(i - (size_t)M * 256) / 512 * 3072 + (i % 512)]); else v = 0.f;
#endif
            a.out[i] = v;
        }
    }
#elif defined(DBG_NOFINAL)
#else
    if (IN_RANGE()) {
        FRESH_IDS(); (void)tid2; const int lane = lane2, gw = vcu * 8 + wid2;
        const float* fg = (const float*)karg(30); const float* ssqf = SSQC;
        for (int m = gw; m < M; m += NGW) { const u32x2* xs = (const u32x2*)(MGb + (size_t)m * D) + lane; f32x4* xr = (f32x4*)(a.out + (size_t)m * D) + lane; const float rs = pg8::rstd_row(ssqf, m);
#pragma unroll
            for (int j = 0; j < 4; ++j) { const f32x4 gv = ((const f32x4*)fg)[lane + 64 * j]; const u32x2 w = xs[64 * j]; const f32x4 xv = (f32x4){bflo(w.x), bfhi(w.x), bflo(w.y), bfhi(w.y)}; xr[64 * j] = xv * rs * gv; } }
    }
#endif
}

extern "C" void kernel_launch(void* const* d_in, const int* in_sizes, int n_in, void* d_out, int out_size, void* d_ws, size_t ws_size, hipStream_t stream) {
    static int grid = 0;
    if (grid == 0) {
        if (n_in != 31 || in_sizes[0] != M * D || out_size != M * D || ws_size < WS_END) { fprintf(stderr, "kernel_launch: unexpected shapes: n_in %d in0 %d out %d ws %zu (need %zu)\n", n_in, n_in > 0 ? in_sizes[0] : -1, out_size, ws_size, (size_t)WS_END); grid = -1; return; }
        int dev = 0, cus = 0, per_cu = 0;
        hipGetDevice(&dev); hipDeviceGetAttribute(&cus, hipDeviceAttributeMultiprocessorCount, dev);
        if (hipFuncSetAttribute((const void*)mega_fwd, hipFuncAttributeMaxDynamicSharedMemorySize, LDS_BYTES) != hipSuccess) { fprintf(stderr, "kernel_launch: hipFuncSetAttribute failed\n"); grid = -1; return; }
        if (hipOccupancyMaxActiveBlocksPerMultiprocessor(&per_cu, (const void*)mega_fwd, 512, LDS_BYTES) != hipSuccess || per_cu < 1) { fprintf(stderr, "kernel_launch: occupancy query says %d\n", per_cu); per_cu = 1; }
        (void)hipGetLastError();
        grid = cus;
        if (grid > 256) grid = 256;
    }
    if (grid < 0) return;
    Args a{};
    for (int i = 0; i < 31; ++i) a.in[i] = d_in[i];
    a.out = (float*)d_out; a.ws = (unsigned char*)d_ws;
    for (int i = 0; i < 8; ++i) a.inv_freq[i] = (float)pow(500000.0, -(double)i / 8.0);
    a.mask = DBG_MASK; a.mask1 = DBG_MASK1;
#if defined(DBG_POISON)
    (void)hipMemsetAsync(d_ws, 0xAA, WS_END, stream); (void)hipMemsetAsync(d_out, 0xAA, (size_t)out_size * 4, stream);
#endif
    if (hipMemsetAsync(d_ws, 0, 65536, stream) != hipSuccess) { fprintf(stderr, "kernel_launch: memset failed\n"); return; }
#if defined(MK_MULTI)
    for (int ph = 0; ph < NPH; ++ph) { a.ph_lo = ph; a.ph_hi = ph + 1; hipLaunchKernelGGL(mega_fwd, dim3(grid), dim3(512), LDS_BYTES, stream, a); }
#else
    a.ph_lo = 0; a.ph_hi = NPH;
    void* args[] = {&a};
    hipError_t e = hipLaunchCooperativeKernel((const void*)mega_fwd, dim3(grid), dim3(512), args, LDS_BYTES, stream);
    if (e != hipSuccess) fprintf(stderr, "kernel_launch: cooperative launch failed: %s (grid %d)\n", hipGetErrorString(e), grid);
#endif
}
```
